# Optimizing an MI355X kernel written in HIP

```python
import math
import jax, jax.numpy as jnp
from jax import lax
import numpy as np

D_MODEL = 1024
BATCH = 8
SEQ = 4096
DEPTH = 2

HEAD_DIM = 64
N_HEADS_FOX = 4
N_HEADS_DIL = 6
N_HEADS_SB = 6
W_FOX = N_HEADS_FOX * HEAD_DIM
W_DIL = N_HEADS_DIL * HEAD_DIM
W_SB = N_HEADS_SB * HEAD_DIM
MIX_WIDTH = W_FOX + W_DIL + W_SB
IN_COLS = 4 * W_FOX + N_HEADS_FOX + 3 * W_DIL + 3 * W_SB
Q_BLOCK = 128
DIL_PATTERNS = ((128, 1), (512, 4), (2048, 16))
FORGET_BIAS_INIT = 2.0
NUM_BUCKETS = 32
MAX_DISTANCE = 2048
N_EXPERTS = 16
N_GROUPS = 4
EXPERTS_PER_GROUP = N_EXPERTS // N_GROUPS
TOP_K = 2
D_FF_EXPERT = 512
RMS_EPS = 1e-6

kernel_name = "hybrid_fox_dilated_stickbreak_grouped_moe"


def rms_norm(x, gain):
    xf = x.astype(jnp.float32)
    y = xf * lax.rsqrt(jnp.mean(xf * xf, axis=-1, keepdims=True) + RMS_EPS)
    return (y * gain.astype(jnp.float32)).astype(x.dtype)


def split_heads(t, n_heads):
    return t.reshape(t.shape[:-1] + (n_heads, HEAD_DIM))


def t5_causal_bucket(distance):
    max_exact = NUM_BUCKETS // 2
    d = jnp.maximum(distance, max_exact).astype(jnp.float32)
    large = max_exact + (jnp.log(d / max_exact) / math.log(MAX_DISTANCE / max_exact)
                         * (NUM_BUCKETS - max_exact)).astype(jnp.int32)
    large = jnp.minimum(large, NUM_BUCKETS - 1)
    return jnp.where(distance < max_exact, distance, large)


def forgetting_attention(q, k, v, log_f):
    b_, s_, h_, e_ = q.shape
    nb = s_ // Q_BLOCK
    scale = e_ ** -0.5
    cum = jnp.cumsum(log_f.astype(jnp.float32), axis=1).transpose(0, 2, 1)
    q_blocks = q.reshape(b_, nb, Q_BLOCK, h_, e_).transpose(1, 0, 2, 3, 4)
    c_blocks = cum.reshape(b_, h_, nb, Q_BLOCK).transpose(2, 0, 1, 3)
    starts = jnp.arange(nb, dtype=jnp.int32) * Q_BLOCK
    key_pos = jnp.arange(s_, dtype=jnp.int32)

    def one_block(args):
        q_blk, c_blk, start = args
        logits = jnp.einsum('bqhe,bkhe->bhqk', q_blk, k).astype(jnp.float32) * scale
        logits = logits + c_blk[..., None] - cum[:, :, None, :]
        q_pos = start + jnp.arange(Q_BLOCK, dtype=jnp.int32)
        causal = key_pos[None, :] <= q_pos[:, None]
        p = jax.nn.softmax(jnp.where(causal, logits, -jnp.inf), axis=-1)
        return jnp.einsum('bhqk,bkhe->bqhe', p.astype(v.dtype), v)

    out = lax.map(one_block, (q_blocks, c_blocks, starts))
    return out.transpose(1, 0, 2, 3, 4).reshape(b_, s_, h_, e_)


def stick_breaking_attention(q, k, v):
    b_, s_, h_, e_ = q.shape
    nb = s_ // Q_BLOCK
    scale = e_ ** -0.5
    q_blocks = q.reshape(b_, nb, Q_BLOCK, h_, e_).transpose(1, 0, 2, 3, 4)
    starts = jnp.arange(nb, dtype=jnp.int32) * Q_BLOCK
    key_pos = jnp.arange(s_, dtype=jnp.int32)

    def one_block(args):
        q_blk, start = args
        z = jnp.einsum('bqhe,bkhe->bhqk', q_blk, k).astype(jnp.float32) * scale
        q_pos = start + jnp.arange(Q_BLOCK, dtype=jnp.int32)
        strict = key_pos[None, :] < q_pos[:, None]
        log_keep = jnp.where(strict, jax.nn.log_sigmoid(-z), 0.0)
        later = lax.cumsum(log_keep, axis=3, reverse=True) - log_keep
        a = jnp.where(strict, jnp.exp(jax.nn.log_sigmoid(z) + later), 0.0)
        return jnp.einsum('bhqk,bkhe->bqhe', a.astype(v.dtype), v)

    out = lax.map(one_block, (q_blocks, starts))
    return out.transpose(1, 0, 2, 3, 4).reshape(b_, s_, h_, e_)


def dilated_window_attention(q, k, v, rel_bias):
    b_, s_, h_, e_ = q.shape
    scale = e_ ** -0.5
    outs, lses = [], []
    q_loc = jnp.arange(Q_BLOCK, dtype=jnp.int32)
    k_loc = jnp.arange(2 * Q_BLOCK, dtype=jnp.int32)
    steps = q_loc[:, None] + Q_BLOCK - k_loc[None, :]
    for window, dil in DIL_PATTERNS:
        span = window // dil
        unit = dil * Q_BLOCK
        s_pad = -(-s_ // unit) * unit
        m = s_pad // dil
        nb = m // Q_BLOCK

        def to_blocks(t):
            t = jnp.pad(t, ((0, 0), (0, s_pad - s_), (0, 0), (0, 0)))
            t = t.reshape(b_, m, dil, h_, e_).transpose(0, 2, 3, 1, 4)
            return t.reshape(b_, dil, h_, nb, Q_BLOCK, e_)

        def with_prev(t):
            prev = jnp.pad(t, ((0, 0), (0, 0), (0, 0), (1, 0), (0, 0), (0, 0)))[:, :, :, :-1]
            return jnp.concatenate([prev, t], axis=4)

        qb = to_blocks(q)
        kw = with_prev(to_blocks(k))
        vw = with_prev(to_blocks(v))
        logits = jnp.einsum('brhnqe,brhnke->brhnqk', qb, kw).astype(jnp.float32) * scale
        bias = rel_bias[t5_causal_bucket(jnp.maximum(steps, 0) * dil)].transpose(2, 0, 1)
        band = (steps >= 0) & (steps <= span)
        key_exists = (jnp.arange(nb)[:, None] > 0) | (k_loc[None, :] >= Q_BLOCK)
        mask = band[None, :, :] & key_exists[:, None, :]
        logits = jnp.where(mask, logits + bias[:, None].astype(jnp.float32), -jnp.inf)
        lse = jax.nn.logsumexp(logits, axis=-1)
        p = jnp.exp(logits - lse[..., None])
        o = jnp.einsum('brhnqk,brhnke->brhnqe', p.astype(v.dtype), vw)
        o = o.reshape(b_, dil, h_, m, e_).transpose(0, 3, 1, 2, 4).reshape(b_, s_pad, h_, e_)[:, :s_]
        lse = lse.reshape(b_, dil, h_, m).transpose(0, 3, 1, 2).reshape(b_, s_pad, h_)[:, :s_]
        outs.append(o)
        lses.append(lse)
    weights = jax.nn.softmax(jnp.stack(lses, axis=0), axis=0)
    return jnp.sum(weights[..., None].astype(v.dtype) * jnp.stack(outs, axis=0), axis=0)


def hybrid_mixer(h, w_in, b_forget, q_gain_fox, k_gain_fox, q_gain_dil, k_gain_dil, rel_bias, w_out):
    b_, s_, _ = h.shape
    proj = jnp.einsum('bsd,dc->bsc', h, w_in)
    sizes = [W_FOX, W_FOX, W_FOX, W_FOX, N_HEADS_FOX, W_DIL, W_DIL, W_DIL, W_SB, W_SB, W_SB]
    points = [int(p) for p in np.cumsum(sizes)[:-1]]
    q_f, k_f, v_f, g_f, f_logit, q_d, k_d, v_d, q_s, k_s, v_s = jnp.split(proj, points, axis=-1)
    log_f = jax.nn.log_sigmoid(f_logit.astype(jnp.float32) + b_forget.astype(jnp.float32))
    o_fox = forgetting_attention(rms_norm(split_heads(q_f, N_HEADS_FOX), q_gain_fox),
                                 rms_norm(split_heads(k_f, N_HEADS_FOX), k_gain_fox),
                                 split_heads(v_f, N_HEADS_FOX), log_f)
    o_fox = o_fox.reshape(b_, s_, W_FOX) * jax.nn.sigmoid(g_f)
    o_dil = dilated_window_attention(rms_norm(split_heads(q_d, N_HEADS_DIL), q_gain_dil),
                                     rms_norm(split_heads(k_d, N_HEADS_DIL), k_gain_dil),
                                     split_heads(v_d, N_HEADS_DIL), rel_bias).reshape(b_, s_, W_DIL)
    o_sb = stick_breaking_attention(split_heads(q_s, N_HEADS_SB), split_heads(k_s, N_HEADS_SB),
                                    split_heads(v_s, N_HEADS_SB)).reshape(b_, s_, W_SB)
    mixed = jnp.concatenate([o_fox, o_dil, o_sb], axis=-1)
    return jnp.einsum('bsc,cd->bsd', mixed, w_out)


def grouped_moe(h, router_w, router_b, w_gate, w_up, w_down):
    b_, s_, d_ = h.shape
    tokens = h.reshape(-1, d_)
    probs = jax.nn.softmax((tokens @ router_w).astype(jnp.float32) + router_b.astype(jnp.float32), axis=-1)
    grouped = probs.reshape(-1, N_GROUPS, EXPERTS_PER_GROUP)
    group_score = lax.top_k(grouped, TOP_K)[0].sum(-1)
    best_group = jnp.argmax(group_score, axis=-1)
    in_group = jnp.take_along_axis(grouped, best_group[:, None, None], axis=1)[:, 0]
    top_p, top_local = lax.top_k(in_group, TOP_K)
    expert_idx = best_group[:, None] * EXPERTS_PER_GROUP + top_local
    gates = top_p / jnp.sum(top_p, axis=-1, keepdims=True)
    combine = jnp.sum(jax.nn.one_hot(expert_idx, N_EXPERTS, dtype=jnp.float32) * gates[..., None], axis=1)
    combine = combine.astype(tokens.dtype)
    out = jnp.zeros_like(tokens)
    for e in range(N_EXPERTS):
        hid = jax.nn.silu(tokens @ w_gate[e]) * (tokens @ w_up[e])
        out = out + combine[:, e:e + 1] * (hid @ w_down[e])
    return out.reshape(b_, s_, d_)


def setup_inputs(seed: int = 0) -> dict:
    key = jax.random.key(seed)
    ks = jax.random.split(key, 19)
    f32 = jnp.float32

    def nrm(k, shape, scale):
        return jax.random.normal(k, shape, f32) * scale

    return {
        'x': nrm(ks[0], (BATCH, SEQ, D_MODEL), 1.0),
        'c': nrm(ks[1], (BATCH, D_MODEL), 1.0),
        'ada_w': nrm(ks[2], (DEPTH, D_MODEL, 6 * D_MODEL), 0.5 * D_MODEL ** -0.5),
        'ada_b': nrm(ks[3], (DEPTH, 6 * D_MODEL), 0.02),
        'norm_mix': 1.0 + nrm(ks[4], (DEPTH, D_MODEL), 0.02),
        'norm_ffn': 1.0 + nrm(ks[5], (DEPTH, D_MODEL), 0.02),
        'w_in': nrm(ks[6], (DEPTH, D_MODEL, IN_COLS), D_MODEL ** -0.5),
        'b_forget': FORGET_BIAS_INIT + nrm(ks[7], (DEPTH, N_HEADS_FOX), 0.1),
        'q_gain_fox': 1.0 + nrm(ks[8], (DEPTH, HEAD_DIM), 0.02),
        'k_gain_fox': 1.0 + nrm(ks[9], (DEPTH, HEAD_DIM), 0.02),
        'q_gain_dil': 1.0 + nrm(ks[10], (DEPTH, HEAD_DIM), 0.02),
        'k_gain_dil': 1.0 + nrm(ks[11], (DEPTH, HEAD_DIM), 0.02),
        'rel_bias': nrm(ks[12], (NUM_BUCKETS, N_HEADS_DIL), 0.2),
        'w_out': nrm(ks[13], (DEPTH, MIX_WIDTH, D_MODEL), MIX_WIDTH ** -0.5),
        'router_w': nrm(ks[14], (D_MODEL, N_EXPERTS), D_MODEL ** -0.5),
        'router_b': nrm(ks[15], (N_EXPERTS,), 0.01),
        'w_gate': nrm(ks[16], (DEPTH, N_EXPERTS, D_MODEL, D_FF_EXPERT), D_MODEL ** -0.5),
        'w_up': nrm(ks[17], (DEPTH, N_EXPERTS, D_MODEL, D_FF_EXPERT), D_MODEL ** -0.5),
        'w_down': nrm(ks[18], (DEPTH, N_EXPERTS, D_FF_EXPERT, D_MODEL), D_FF_EXPERT ** -0.5),
    }


def reference(x, c, ada_w, ada_b, norm_mix, norm_ffn, w_in, b_forget, q_gain_fox, k_gain_fox,
              q_gain_dil, k_gain_dil, rel_bias, w_out, router_w, router_b, w_gate, w_up, w_down):
    cond = jax.nn.silu(c)
    for layer in range(DEPTH):
        mod = jnp.einsum('bd,de->be', cond, ada_w[layer]) + ada_b[layer]
        shift_m, scale_m, gate_m, shift_f, scale_f, gate_f = jnp.split(mod[:, None, :], 6, axis=-1)
        h = rms_norm(x, norm_mix[layer]) * (1.0 + scale_m) + shift_m
        x = x + gate_m * hybrid_mixer(h, w_in[layer], b_forget[layer], q_gain_fox[layer], k_gain_fox[layer],
                                      q_gain_dil[layer], k_gain_dil[layer], rel_bias, w_out[layer])
        h = rms_norm(x, norm_ffn[layer]) * (1.0 + scale_f) + shift_f
        x = x + gate_f * grouped_moe(h, router_w, router_b, w_gate[layer], w_up[layer], w_down[layer])
    return x
```

```cpp
#include <hip/hip_runtime.h>
#include <cstdio>
#include <cstdint>

#define GAS __attribute__((address_space(1)))
#define LAS __attribute__((address_space(3)))
typedef unsigned short bf16_t;
typedef float f32x4 __attribute__((ext_vector_type(4)));
typedef unsigned u32x4 __attribute__((ext_vector_type(4)));
typedef unsigned u32x2 __attribute__((ext_vector_type(2)));

constexpr int NB = 8, S = 4096, D = 1024, NTOK = NB * S, NL = 2;
constexpr int HD = 64, NSLOT = 52, IN_COLS = 3332;
constexpr int NE = 16, DFF = 512;
constexpr int NWAVES = 8, NTHR = 512;
constexpr float RMS_EPS = 1e-6f;
constexpr float LOG2E = 1.4426950408889634f;
constexpr float LN2 = 0.6931471805599453f;

enum SlotType { ST_QFOX = 0, ST_KFOX, ST_V, ST_G, ST_QDIL, ST_KDIL, ST_QSB, ST_K };
__host__ __device__ constexpr int slot_col(int s) {
    return s < 16 ? 64 * s : 1028 + 64 * (s - 16);
}
__host__ __device__ constexpr int slot_type(int s) {
    return s < 4 ? ST_QFOX : s < 8 ? ST_KFOX : s < 12 ? ST_V : s < 16 ? ST_G : s < 22 ? ST_QDIL : s < 28 ? ST_KDIL : s < 34 ? ST_V : s < 40 ? ST_QSB : s < 46 ? ST_K : ST_V;
}

constexpr size_t MiB = 1u << 20;
constexpr size_t WS_CTL = 0, CTL_ZERO_BYTES = 1 * MiB;
constexpr size_t WS_MOD = 1 * MiB;
constexpr size_t WS_FLOG = WS_MOD + 512 * 1024;
constexpr size_t WS_CUM = 2 * MiB;
constexpr size_t WS_LIST = 3 * MiB;
constexpr size_t WS_LISTW = 5 * MiB;
constexpr size_t WS_DILL = 7 * MiB;
constexpr size_t WS_WIN = 10 * MiB;
constexpr size_t WS_WOUT = 23 * MiB;
constexpr size_t WS_WGU = 27 * MiB;
constexpr size_t WS_WDN = 91 * MiB;
constexpr size_t WS_ACT = 124 * MiB;
constexpr size_t WS_PROJ = 188 * MiB;
constexpr size_t WS_HS = 188 * MiB;
constexpr size_t WS_HID = 324 * MiB;
constexpr size_t WS_YBUF = 188 * MiB;
constexpr size_t WS_XB = 396 * MiB;
constexpr size_t WS_END = 468 * MiB;
constexpr int CW_BAR = 4096;
constexpr int CW_CNT = 16384;
constexpr int LDS_BYTES = 147456;
constexpr int MISC_OFF = 138240;
constexpr int SEG_OFF = 138752;

#ifndef MF_FOX
#define MF_FOX 1
#endif
#ifndef MF_DIL
#define MF_DIL 1
#endif
#ifndef MF_SB
#define MF_SB 1
#endif
__device__ __forceinline__ float bf2f(bf16_t v) { return __uint_as_float(((unsigned)v) << 16); }
__device__ __forceinline__ unsigned f2bf(float f) { unsigned u = __float_as_uint(f); return (u + 0x7fffu + ((u >> 16) & 1u)) >> 16; }
typedef float pk2_f32x2 __attribute__((ext_vector_type(2))); typedef __bf16 pk2_bf16x2 __attribute__((ext_vector_type(2)));
__device__ __forceinline__ unsigned pk2(float lo, float hi) { pk2_f32x2 v = {lo, hi}; pk2_bf16x2 b = __builtin_convertvector(v, pk2_bf16x2); return __builtin_bit_cast(unsigned, b); }
__device__ __forceinline__ float wave_sum(float v) {
#pragma unroll
    for (int o = 1; o < 64; o <<= 1) v += __shfl_xor(v, o);
    return v;
}
__device__ __forceinline__ float log_sigmoid_f(float v) { return fminf(v, 0.f) - log1pf(expf(-fabsf(v))); }

#define XB_TMO      128
#define XB_XCNT(j)  (256  + 64 * (j))
#define XB_XSUB(j)  (1280 + 64 * (j))
#define XB_XGEN(j)  (2304 + 64 * (j))
#define XB_TOP      3328
#define XB_TOPGEN   3392
#define XCD_BAR_WORDS 3456
#define XB_SPIN_CAP (1u << 24)
__device__ __forceinline__ unsigned xb_ld(unsigned* p)              { return __hip_atomic_load(p, __ATOMIC_RELAXED, __HIP_MEMORY_SCOPE_AGENT); }
__device__ __forceinline__ unsigned xb_add(unsigned* p, unsigned v) { return __hip_atomic_fetch_add(p, v, __ATOMIC_RELAXED, __HIP_MEMORY_SCOPE_AGENT); }
__device__ __forceinline__ unsigned xb_xcc_id() { return (unsigned)__builtin_amdgcn_s_getreg((3 << 11) | 20) & 0xFu; }
#define XB_SPIN(cond, bar) do { unsigned _sp = 0; while (cond) { __builtin_amdgcn_s_sleep(1); \
    if ((++_sp & 255u) == 0u) { if (xb_ld(&(bar)[XB_TMO])) break; if (_sp > XB_SPIN_CAP) { atomicAdd(&(bar)[XB_TMO], 1u); break; } } } } while (0)
struct XcdBarrier { unsigned* bar; unsigned x; volatile LAS unsigned* st; };
__device__ __forceinline__ XcdBarrier xcd_barrier_post(unsigned* bar, volatile LAS unsigned* st) {
    XcdBarrier b; b.bar = bar; b.x = xb_xcc_id(); b.st = st;
    if (threadIdx.x == 0) (void)xb_add(&bar[XB_XCNT(b.x)], 1u);
    return b;
}
__device__ __forceinline__ void xcd_barrier_complete(unsigned* bar, unsigned x, unsigned& nloc, unsigned& nx) {
    const unsigned G = gridDim.x * gridDim.y * gridDim.z;
    unsigned sum, cnt, mine, sp = 0u;
    for (;;) {
        sum = 0u; cnt = 0u; mine = 0u;
#pragma unroll
        for (unsigned j = 0; j < 16; ++j) { const unsigned c = xb_ld(&bar[XB_XCNT(j)]); sum += c; cnt += (c > 0u) ? 1u : 0u; mine = (j == x) ? c : mine; }
        if (sum == G) break;
        __builtin_amdgcn_s_sleep(1);
        if ((++sp & 255u) == 0u) { if (xb_ld(&bar[XB_TMO])) break; if (sp > XB_SPIN_CAP) { atomicAdd(&bar[XB_TMO], 1u); break; } }
    }
    nloc = mine > 0u ? mine : 1u; nx = cnt > 0u ? cnt : 1u;
}
__device__ __forceinline__ void xcd_barrier(const XcdBarrier& b) {
    asm volatile("s_waitcnt vmcnt(0)" ::: "memory");
    __syncthreads();
    if (threadIdx.x == 0) {
        unsigned* bar = b.bar; unsigned bx = b.x;
        asm volatile("" : "+s"(bar), "+s"(bx));
        __builtin_amdgcn_s_waitcnt(0);
        unsigned nloc = b.st[0], nx = b.st[1];
        if (nloc == 0u) { xcd_barrier_complete(bar, bx, nloc, nx); b.st[0] = nloc; b.st[1] = nx; }
        const unsigned old = xb_add(&bar[XB_XSUB(bx)], 1u);
        const unsigned gen = old / nloc;
        if (old + 1u == (gen + 1u) * nloc) {
            __builtin_amdgcn_fence(__ATOMIC_RELEASE, "agent");
            asm volatile("s_waitcnt vmcnt(0)" ::: "memory");
            const unsigned og = xb_add(&bar[XB_TOP], 1u);
            const unsigned tg = og / nx;
            if (og + 1u == (tg + 1u) * nx) xb_add(&bar[XB_TOPGEN], 1u);
            else XB_SPIN(xb_ld(&bar[XB_TOPGEN]) == tg, bar);
            __builtin_amdgcn_fence(__ATOMIC_ACQUIRE, "agent");
            xb_add(&bar[XB_XGEN(bx)], 1u);
            asm volatile("s_waitcnt vmcnt(0)" ::: "memory");
        } else {
            XB_SPIN(xb_ld(&bar[XB_XGEN(bx)]) == gen, bar);
            __builtin_amdgcn_fence(__ATOMIC_ACQUIRE, "agent");
            asm volatile("s_waitcnt vmcnt(0)" ::: "memory");
        }
    }
    __syncthreads();
}

struct Args { const float* in[19]; float* out; unsigned char* ws; };
enum InIdx { I_X = 0, I_C, I_ADAW, I_ADAB, I_NMIX, I_NFFN, I_WIN, I_BFORGET, I_QGF, I_KGF, I_QGD, I_KGD, I_RELB, I_WOUT, I_RW, I_RB, I_WG, I_WU, I_WD };

__device__ __forceinline__ int opaque_tid() { int t = threadIdx.x; asm volatile("" : "+v"(t)); return t; }

__device__ __forceinline__ void lds_dma4(const void* gsrc, unsigned lds_dst) { unsigned keep;
    asm volatile("s_mov_b32 %0, m0\n\ts_mov_b32 m0, %2\n\ts_nop 0\n\tglobal_load_lds_dword %1, off\n\ts_mov_b32 m0, %0" : "=&s"(keep) : "v"(gsrc), "s"(lds_dst) : "memory"); }
constexpr int DNSL_OFF = 140288;
namespace pg8 {
typedef short bf16x8 __attribute__((ext_vector_type(8)));
constexpr int BM = 256, BK = 64, HALF = 128, HTB = HALF * BK * 2, STAGE_BYTES = 8 * HTB, NXCD = 8, WGM = 8;
__host__ __device__ __forceinline__ int lds_byte(int r, int c) { const int st = (r >> 4) * 2 + (c >> 5), rr = r & 15, cc = c & 31, ob = rr * 64 + cc * 2; return st * 1024 + (ob ^ (((ob >> 9) & 1) << 5)); }
__host__ __device__ __forceinline__ void stage_rc(int b, int& R, int& C) { const int st = b / 1024, sb = b % 1024, swz = sb ^ (((sb >> 9) & 1) << 5); R = (st >> 1) * 16 + swz / 64; C = (st & 1) * 32 + (swz % 64) / 2; }
__host__ __device__ __forceinline__ int perm32(int rho) { const int n = rho >> 4, i = rho & 15; return 8 * (i >> 2) + 4 * n + (i & 3); }
struct Unit { const char* a; const char* b; int pm, pn, e, rows, par; };
__device__ __forceinline__ unsigned cvt_pk_bf16(float lo, float hi) { unsigned r; asm volatile("v_cvt_pk_bf16_f32 %0, %1, %2" : "=v"(r) : "v"(lo), "v"(hi)); return r; }

struct DenseOrder {
    const char* A; const char* Bt; int nM, nN, nwg, G, c; size_t tstep, tstepA;
    __device__ void init(const void* A_, const void* Bt_, int M, int N, int K, int G_, int c_, size_t tstepA_ = 0) { A = (const char*)A_; Bt = (const char*)Bt_; nM = M / BM; nN = N / BM; nwg = nM * nN; G = G_; c = c_; tstep = (size_t)BM * K * 2; tstepA = tstepA_ ? tstepA_ : tstep; }
    __device__ __forceinline__ bool next(int i, Unit& u) const {
        const long L = (long)i * G + c; if (L >= nwg) return false;
        int wgid = (int)L; { const int q = nwg / NXCD, r = nwg % NXCD, xcd = wgid % NXCD, off = wgid / NXCD; wgid = (xcd < r ? xcd * (q + 1) : r * (q + 1) + (xcd - r) * q) + off; }
        const int nig = WGM * nN, gid = wgid / nig, fm = gid * WGM, gsz = (nM - fm) < WGM ? (nM - fm) : WGM;
        u.pm = fm + ((wgid % nig) % gsz); u.pn = (wgid % nig) / gsz; u.e = 0; u.rows = 256;
        u.a = A + (size_t)u.pm * tstepA; u.b = Bt + (size_t)u.pn * tstep; return true;
    }
};
struct GroupedOrder {
    const char* A; const char* Bt; const LAS int* seg; int nct, G, c; size_t arow_bytes, bexp_bytes, btile_bytes;
    __device__ __forceinline__ bool next(int i, Unit& u) const {
        int U = i * G + c, e = 0, found = 0, rem = 0;
        for (int k = 0; k < 16; ++k) { const int nu = ((seg[k] + 255) >> 8) * nct; if (!found) { if (U < nu) { found = 1; e = k; rem = U; } else U -= nu; } }
        if (!found) return false;
        e = __builtin_amdgcn_readfirstlane(e); rem = __builtin_amdgcn_readfirstlane(rem);
        const int rt = rem / nct, ct = rem % nct;
        u.e = e; u.pm = rt; u.pn = ct; u.rows = seg[e] - rt * 256;
        u.a = A + (size_t)(seg[16 + e] + rt * 256) * arow_bytes; u.b = Bt + (size_t)e * bexp_bytes + (size_t)ct * btile_bytes; return true;
    }
};

template <class Epi, class Sched>
__device__ __forceinline__ void gemm_phase(LAS unsigned char* lds, const int K, const Sched& S, const Epi& E, const unsigned lda_in = 0, const size_t kstepA_in = 0) {
    const int tid = opaque_tid(), wid = __builtin_amdgcn_readfirstlane(tid >> 6), lane = tid & 63, wr = wid >> 2, wc = wid & 3, fr = lane & 15, fq = lane >> 4;
    const int nt = K / BK;
    const unsigned ldaA = lda_in ? lda_in : (unsigned)(K * 2);
    unsigned voffA[2], voffB[2];
#pragma unroll
    for (int i = 0; i < 2; ++i) { int R, C; stage_rc(tid * 16 + i * 8192, R, C); const int Rb = Epi::PERM ? ((R & ~31) + perm32(R & 31)) : R;
        voffA[i] = (unsigned)R * ldaA + (unsigned)C * 2u; voffB[i] = (unsigned)(Rb * K + C) * 2u; }
    const size_t kstep = (size_t)(BK * 2);
    const size_t hstep = (size_t)HALF * K * 2;
    const size_t kstepA = kstepA_in ? kstepA_in : kstep, hstepA = (size_t)HALF * ldaA;
    const unsigned ldsw = (unsigned)wid * 1024u;
    const int aoff = lds_byte(wr * 64 + fr, fq * 8), boff = lds_byte(wc * 32 + fr, fq * 8);
#define PG8_SA(b, h) (((b) * 2 + (h)) * HTB)
#define PG8_SB(b, h) ((4 + (b) * 2 + (h)) * HTB)
#define PG8_STAGE(bufoff, gbase, voff) do { _Pragma("unroll") for (int _i = 0; _i < 2; ++_i) \
        __builtin_amdgcn_global_load_lds((const unsigned*)((const char*)(gbase) + (voff)[_i]), (LAS unsigned*)(lds + (bufoff) + ldsw + _i * 8192), 16, 0, 0); } while (0)
#define PG8_LDA(dst, b, h) do { _Pragma("unroll") for (int m = 0; m < 4; ++m) _Pragma("unroll") for (int k = 0; k < 2; ++k) dst[m][k] = *(const LAS bf16x8*)(lds + PG8_SA(b, h) + aoff + m * 2048 + k * 1024); } while (0)
#define PG8_LDB(dst, b, h) do { _Pragma("unroll") for (int n = 0; n < 2; ++n) _Pragma("unroll") for (int k = 0; k < 2; ++k) dst[n][k] = *(const LAS bf16x8*)(lds + PG8_SB(b, h) + boff + n * 2048 + k * 1024); } while (0)
#define PG8_MMA(ai, bj, At, Bt) do { __builtin_amdgcn_s_setprio(1); _Pragma("unroll") for (int m = 0; m < 4; ++m) _Pragma("unroll") for (int n = 0; n < 2; ++n) _Pragma("unroll") for (int k = 0; k < 2; ++k) \
        acc[ai][bj][m][n] = __builtin_amdgcn_mfma_f32_16x16x32_bf16(Bt[n][k], At[m][k], acc[ai][bj][m][n], 0, 0, 0); __builtin_amdgcn_s_setprio(0); } while (0)
#define PG8_WAIT_V(n) asm volatile("s_waitcnt vmcnt(" #n ")" ::: "memory")
#define PG8_WAIT_L(n) asm volatile("s_waitcnt lgkmcnt(" #n ")" ::: "memory")
#define PG8_BAR __builtin_amdgcn_s_barrier()
#define PG8_SCHED __builtin_amdgcn_sched_barrier(0)
    Unit cur, nxt; int ui = 0;
    if (!S.next(0, cur)) return;
    f32x4 acc[2][2][4][2];
#pragma unroll
    for (int a = 0; a < 2; ++a)
#pragma unroll
        for (int b = 0; b < 2; ++b)
#pragma unroll
            for (int m = 0; m < 4; ++m)
#pragma unroll
                for (int n = 0; n < 2; ++n) acc[a][b][m][n] = (f32x4){0.f, 0.f, 0.f, 0.f};
    bf16x8 At[4][2], B0[2][2], B1[2][2];
    const char* cA = cur.a; const char* cB = cur.b;
    PG8_STAGE(PG8_SB(0, 0), cB, voffB); PG8_STAGE(PG8_SB(0, 1), cB + hstep, voffB); PG8_STAGE(PG8_SA(0, 0), cA, voffA); PG8_STAGE(PG8_SA(0, 1), cA + hstepA, voffA);
    if (wr == 1) PG8_BAR;
    PG8_WAIT_V(2); PG8_BAR;
    PG8_STAGE(PG8_SB(1, 0), cB + kstep, voffB); PG8_STAGE(PG8_SA(1, 0), cA + kstepA, voffA); PG8_STAGE(PG8_SB(1, 1), cB + hstep + kstep, voffB);
    PG8_WAIT_V(6); PG8_BAR;
    for (;;) {
        const bool hi_on = cur.rows > 128;
        cur.par = ui & 1; E.pre(lds, cur, tid);
        const bool has_next = S.next(ui + 1, nxt);
        const char* nA = has_next ? nxt.a : cA; const char* nB = has_next ? nxt.b : cB;
        for (int t = 0; t < nt; t += 2) {
            const bool last = (t == nt - 2);
            const char* a1 = cA + (size_t)(t + 1) * kstepA;
            const char* a2 = last ? nA : cA + (size_t)(t + 2) * kstepA; const char* b2 = last ? nB : cB + (size_t)(t + 2) * kstep;
            const char* a3 = a2 + kstepA; const char* b3 = b2 + kstep;
            PG8_LDB(B0, 0, 0); PG8_LDB(B1, 0, 1); PG8_SCHED; PG8_LDA(At, 0, 0); PG8_STAGE(PG8_SA(1, 1), a1 + hstepA, voffA);
            PG8_WAIT_V(8); PG8_WAIT_L(0); PG8_BAR; PG8_MMA(0, 0, At, B0); PG8_MMA(0, 1, At, B1); PG8_BAR; PG8_SCHED;
            PG8_LDA(At, 0, 1); PG8_STAGE(PG8_SB(0, 0), b2, voffB); PG8_STAGE(PG8_SB(0, 1), b2 + hstep, voffB); PG8_STAGE(PG8_SA(0, 0), a2, voffA);
            PG8_WAIT_V(8); PG8_WAIT_L(0); PG8_BAR; if (hi_on) { PG8_MMA(1, 0, At, B0); PG8_MMA(1, 1, At, B1); } PG8_BAR; PG8_SCHED;
            PG8_LDB(B0, 1, 0); PG8_LDB(B1, 1, 1); PG8_SCHED; PG8_LDA(At, 1, 0); PG8_STAGE(PG8_SA(0, 1), a2 + hstepA, voffA);
            PG8_WAIT_V(8); PG8_WAIT_L(0); PG8_BAR; PG8_MMA(0, 0, At, B0); PG8_MMA(0, 1, At, B1); PG8_BAR; PG8_SCHED;
            PG8_LDA(At, 1, 1); PG8_STAGE(PG8_SB(1, 0), b3, voffB); PG8_STAGE(PG8_SB(1, 1), b3 + hstep, voffB); PG8_STAGE(PG8_SA(1, 0), a3, voffA);
            PG8_WAIT_V(8); PG8_WAIT_L(0); PG8_BAR; if (hi_on) { PG8_MMA(1, 0, At, B0); PG8_MMA(1, 1, At, B1); } PG8_BAR; PG8_SCHED;
        }
        if (wr == 0) PG8_BAR;
        E(acc, cur, wr, wc, fr, fq);
        if (!has_next) break;
#pragma unroll
        for (int a = 0; a < 2; ++a)
#pragma unroll
            for (int b = 0; b < 2; ++b)
#pragma unroll
                for (int m = 0; m < 4; ++m)
#pragma unroll
                    for (int n = 0; n < 2; ++n) acc[a][b][m][n] = (f32x4){0.f, 0.f, 0.f, 0.f};
        cur = nxt; cA = nA; cB = nB; ++ui;
        if (wr == 1) PG8_BAR;
    }
    PG8_WAIT_V(0);
    PG8_BAR;
#undef PG8_SA
#undef PG8_SB
#undef PG8_STAGE
#undef PG8_LDA
#undef PG8_LDB
#undef PG8_MMA
#undef PG8_WAIT_V
#undef PG8_WAIT_L
#undef PG8_BAR
#undef PG8_SCHED
}
template <class Epi, class Sched>
__device__ __forceinline__ void gemm_phase_gather(LAS unsigned char* lds, const int K, const Sched& S, const Epi& E, const char* Ag, const int* list, const LAS int* seg) {
    const int tid = opaque_tid(), wid = __builtin_amdgcn_readfirstlane(tid >> 6), lane = tid & 63, wr = wid >> 2, wc = wid & 3, fr = lane & 15, fq = lane >> 4;
    const int nt = K / BK;
    unsigned voffB[2]; int rowA[2]; unsigned colA[2];
#pragma unroll
    for (int i = 0; i < 2; ++i) { int R, C; stage_rc(tid * 16 + i * 8192, R, C); const int Rb = Epi::PERM ? ((R & ~31) + perm32(R & 31)) : R;
        rowA[i] = R; colA[i] = (unsigned)C * 2u; voffB[i] = (unsigned)(Rb * K + C) * 2u; }
    unsigned ca0[2], ca1[2], na0[2], na1[2];
#define PG8_ROWS(uu, d0, d1) do { const int cnt_ = seg[(uu).e]; _Pragma("unroll") for (int _i = 0; _i < 2; ++_i) { \
        int r0_ = (uu).pm * 256 + rowA[_i], r1_ = r0_ + 128; r0_ = r0_ < cnt_ ? r0_ : cnt_ - 1; r1_ = r1_ < cnt_ ? r1_ : cnt_ - 1; \
        (d0)[_i] = (unsigned)(list[(uu).e * NTOK + r0_] >> 1) * (unsigned)(K * 2) + colA[_i]; (d1)[_i] = (unsigned)(list[(uu).e * NTOK + r1_] >> 1) * (unsigned)(K * 2) + colA[_i]; } } while (0)
    const size_t kstep = (size_t)(BK * 2);
    const size_t hstep = (size_t)HALF * K * 2;
    const unsigned ldsw = (unsigned)wid * 1024u;
    const int aoff = lds_byte(wr * 64 + fr, fq * 8), boff = lds_byte(wc * 32 + fr, fq * 8);
#define PG8_SA(b, h) (((b) * 2 + (h)) * HTB)
#define PG8_SB(b, h) ((4 + (b) * 2 + (h)) * HTB)
#define PG8_STAGE(bufoff, gbase, voff) do { _Pragma("unroll") for (int _i = 0; _i < 2; ++_i) \
        __builtin_amdgcn_global_load_lds((const unsigned*)((const char*)(gbase) + (voff)[_i]), (LAS unsigned*)(lds + (bufoff) + ldsw + _i * 8192), 16, 0, 0); } while (0)
#define PG8_LDA(dst, b, h) do { _Pragma("unroll") for (int m = 0; m < 4; ++m) _Pragma("unroll") for (int k = 0; k < 2; ++k) dst[m][k] = *(const LAS bf16x8*)(lds + PG8_SA(b, h) + aoff + m * 2048 + k * 1024); } while (0)
#define PG8_LDB(dst, b, h) do { _Pragma("unroll") for (int n = 0; n < 2; ++n) _Pragma("unroll") for (int k = 0; k < 2; ++k) dst[n][k] = *(const LAS bf16x8*)(lds + PG8_SB(b, h) + boff + n * 2048 + k * 1024); } while (0)
#define PG8_MMA(ai, bj, At, Bt) do { __builtin_amdgcn_s_setprio(1); _Pragma("unroll") for (int m = 0; m < 4; ++m) _Pragma("unroll") for (int n = 0; n < 2; ++n) _Pragma("unroll") for (int k = 0; k < 2; ++k) \
        acc[ai][bj][m][n] = __builtin_amdgcn_mfma_f32_16x16x32_bf16(Bt[n][k], At[m][k], acc[ai][bj][m][n], 0, 0, 0); __builtin_amdgcn_s_setprio(0); } while (0)
#define PG8_WAIT_V(n) asm volatile("s_waitcnt vmcnt(" #n ")" ::: "memory")
#define PG8_WAIT_L(n) asm volatile("s_waitcnt lgkmcnt(" #n ")" ::: "memory")
#define PG8_BAR __builtin_amdgcn_s_barrier()
#define PG8_SCHED __builtin_amdgcn_sched_barrier(0)
    Unit cur, nxt, nxt2; int ui = 0;
    if (!S.next(0, cur)) return;
    f32x4 acc[2][2][4][2];
#pragma unroll
    for (int a = 0; a < 2; ++a)
#pragma unroll
        for (int b = 0; b < 2; ++b)
#pragma unroll
            for (int m = 0; m < 4; ++m)
#pragma unroll
                for (int n = 0; n < 2; ++n) acc[a][b][m][n] = (f32x4){0.f, 0.f, 0.f, 0.f};
    bf16x8 At[4][2], B0[2][2], B1[2][2];
    const char* cA = Ag; const char* cB = cur.b;
    bool has_next = S.next(1, nxt);
    PG8_ROWS(cur, ca0, ca1);
    if (has_next) PG8_ROWS(nxt, na0, na1); else { na0[0] = ca0[0]; na0[1] = ca0[1]; na1[0] = ca1[0]; na1[1] = ca1[1]; }
    asm volatile("" : "+v"(ca0[0]), "+v"(ca0[1]), "+v"(ca1[0]), "+v"(ca1[1]), "+v"(na0[0]), "+v"(na0[1]), "+v"(na1[0]), "+v"(na1[1]));
    PG8_STAGE(PG8_SB(0, 0), cB, voffB); PG8_STAGE(PG8_SB(0, 1), cB + hstep, voffB); PG8_STAGE(PG8_SA(0, 0), cA, ca0); PG8_STAGE(PG8_SA(0, 1), cA, ca1);
    if (wr == 1) PG8_BAR;
    PG8_WAIT_V(2); PG8_BAR;
    PG8_STAGE(PG8_SB(1, 0), cB + kstep, voffB); PG8_STAGE(PG8_SA(1, 0), cA + kstep, ca0); PG8_STAGE(PG8_SB(1, 1), cB + hstep + kstep, voffB);
    PG8_WAIT_V(6); PG8_BAR;
    for (;;) {
        const bool hi_on = cur.rows > 128;
        const char* nB = has_next ? nxt.b : cB;
        for (int t = 0; t < nt; t += 2) {
            const bool last = (t == nt - 2);
            const char* a1 = cA + (size_t)(t + 1) * kstep;
            const char* a2 = last ? cA : cA + (size_t)(t + 2) * kstep; const char* b2 = last ? nB : cB + (size_t)(t + 2) * kstep;
            unsigned x0[2], x1[2];
            x0[0] = last ? na0[0] : ca0[0]; x0[1] = last ? na0[1] : ca0[1]; x1[0] = last ? na1[0] : ca1[0]; x1[1] = last ? na1[1] : ca1[1];
            const char* a3 = a2 + kstep; const char* b3 = b2 + kstep;
            PG8_LDB(B0, 0, 0); PG8_LDB(B1, 0, 1); PG8_SCHED; PG8_LDA(At, 0, 0); PG8_STAGE(PG8_SA(1, 1), a1, ca1);
            PG8_WAIT_V(8); PG8_WAIT_L(0); PG8_BAR; PG8_MMA(0, 0, At, B0); PG8_MMA(0, 1, At, B1); PG8_BAR; PG8_SCHED;
            PG8_LDA(At, 0, 1); PG8_STAGE(PG8_SB(0, 0), b2, voffB); PG8_STAGE(PG8_SB(0, 1), b2 + hstep, voffB); PG8_STAGE(PG8_SA(0, 0), a2, x0);
            PG8_WAIT_V(8); PG8_WAIT_L(0); PG8_BAR; if (hi_on) { PG8_MMA(1, 0, At, B0); PG8_MMA(1, 1, At, B1); } PG8_BAR; PG8_SCHED;
            PG8_LDB(B0, 1, 0); PG8_LDB(B1, 1, 1); PG8_SCHED; PG8_LDA(At, 1, 0); PG8_STAGE(PG8_SA(0, 1), a2, x1);
            PG8_WAIT_V(8); PG8_WAIT_L(0); PG8_BAR; PG8_MMA(0, 0, At, B0); PG8_MMA(0, 1, At, B1); PG8_BAR; PG8_SCHED;
            PG8_LDA(At, 1, 1); PG8_STAGE(PG8_SB(1, 0), b3, voffB); PG8_STAGE(PG8_SB(1, 1), b3 + hstep, voffB); PG8_STAGE(PG8_SA(1, 0), a3, x0);
            PG8_WAIT_V(8); PG8_WAIT_L(0); PG8_BAR; if (hi_on) { PG8_MMA(1, 0, At, B0); PG8_MMA(1, 1, At, B1); } PG8_BAR; PG8_SCHED;
        }
        Unit nx2; const bool has_nx2 = has_next && S.next(ui + 2, nx2);
        if (has_nx2) PG8_ROWS(nx2, ca0, ca1); else { ca0[0] = na0[0]; ca0[1] = na0[1]; ca1[0] = na1[0]; ca1[1] = na1[1]; }
        if (wr == 0) PG8_BAR;
        E(acc, cur, wr, wc, fr, fq);
        asm volatile("" : "+v"(ca0[0]), "+v"(ca0[1]), "+v"(ca1[0]), "+v"(ca1[1]));
        if (!has_next) break;
        { unsigned t_; t_ = ca0[0]; ca0[0] = na0[0]; na0[0] = t_; t_ = ca0[1]; ca0[1] = na0[1]; na0[1] = t_; t_ = ca1[0]; ca1[0] = na1[0]; na1[0] = t_; t_ = ca1[1]; ca1[1] = na1[1]; na1[1] = t_; }
        has_next = has_nx2; if (has_nx2) nxt2 = nx2;
#pragma unroll
        for (int a = 0; a < 2; ++a)
#pragma unroll
            for (int b = 0; b < 2; ++b)
#pragma unroll
                for (int m = 0; m < 4; ++m)
#pragma unroll
                    for (int n = 0; n < 2; ++n) acc[a][b][m][n] = (f32x4){0.f, 0.f, 0.f, 0.f};
        cur = nxt; cB = nB; ++ui; nxt = nxt2;
        if (wr == 1) PG8_BAR;
    }
    PG8_WAIT_V(0);
    PG8_BAR;
#undef PG8_SA
#undef PG8_SB
#undef PG8_STAGE
#undef PG8_LDA
#undef PG8_LDB
#undef PG8_MMA
#undef PG8_WAIT_V
#undef PG8_WAIT_L
#undef PG8_BAR
#undef PG8_SCHED
#undef PG8_ROWS
}
}

struct EpiProj {
    static constexpr bool PERM = true;
    __device__ __forceinline__ void pre(LAS unsigned char*, const pg8::Unit&, int) const {}
    bf16_t* proj; const LAS float* gl;
    __device__ __forceinline__ void operator()(const f32x4 (&acc)[2][2][4][2], const pg8::Unit& u, int wr, int wc, int fr, int fq) const {
        const int slot = 4 * u.pn + wc, st = slot_type(slot);
        const bool nrm = (st == ST_QFOX || st == ST_KFOX || st == ST_QDIL || st == ST_KDIL);
        const LAS float* gp = gl + (st == ST_QFOX ? 0 : st == ST_KFOX ? 64 : st == ST_QDIL ? 128 : 192);
        const float sc = (st == ST_QFOX || st == ST_QDIL || st == ST_QSB) ? 0.125f * LOG2E : 1.f;
        f32x4 g[2][2];
#pragma unroll
        for (int bj = 0; bj < 2; ++bj)
#pragma unroll
            for (int n = 0; n < 2; ++n) g[bj][n] = nrm ? *(const LAS f32x4*)(gp + 32 * bj + 8 * fq + 4 * n) * sc : (f32x4){sc, sc, sc, sc};
        bf16_t* base = proj + ((size_t)slot * NTOK + (size_t)u.pm * 256 + wr * 64 + fr) * 64 + 8 * fq;
#pragma unroll
        for (int ai = 0; ai < 2; ++ai)
#pragma unroll
            for (int m = 0; m < 4; ++m) {
                f32x4 v[2][2];
#pragma unroll
                for (int bj = 0; bj < 2; ++bj)
#pragma unroll
                    for (int n = 0; n < 2; ++n) v[bj][n] = acc[ai][bj][m][n];
                float rstd = 1.f;
                if (nrm) {
                    float ss = 0.f;
#pragma unroll
                    for (int bj = 0; bj < 2; ++bj)
#pragma unroll
                        for (int n = 0; n < 2; ++n) ss += (v[bj][n][0] * v[bj][n][0] + v[bj][n][1] * v[bj][n][1]) + (v[bj][n][2] * v[bj][n][2] + v[bj][n][3] * v[bj][n][3]);
                    ss += __shfl_xor(ss, 16); ss += __shfl_xor(ss, 32);
                    rstd = rsqrtf(ss * (1.f / 64.f) + RMS_EPS);
                }
                if (st == ST_G) {
#pragma unroll
                    for (int bj = 0; bj < 2; ++bj)
#pragma unroll
                        for (int n = 0; n < 2; ++n)
#pragma unroll
                            for (int j = 0; j < 4; ++j) v[bj][n][j] = __builtin_amdgcn_rcpf(1.f + __expf(-v[bj][n][j]));
                }
                bf16_t* rowp = base + (size_t)(ai * 128 + m * 16) * 64;
#pragma unroll
                for (int bj = 0; bj < 2; ++bj) {
                    const f32x4 v0 = v[bj][0] * rstd * g[bj][0], v1 = v[bj][1] * rstd * g[bj][1];
                    u32x4 w; w.x = pg8::cvt_pk_bf16(v0[0], v0[1]); w.y = pg8::cvt_pk_bf16(v0[2], v0[3]); w.z = pg8::cvt_pk_bf16(v1[0], v1[1]); w.w = pg8::cvt_pk_bf16(v1[2], v1[3]);
                    *(u32x4*)(rowp + 32 * bj) = w;
                }
            }
    }
};
struct EpiOut {
    static constexpr bool PERM = true;
    __device__ __forceinline__ void pre(LAS unsigned char*, const pg8::Unit&, int) const {}
    const float* xin32; const bf16_t* xin16; bf16_t* out; const float* gm;
    __device__ __forceinline__ void operator()(const f32x4 (&acc)[2][2][4][2], const pg8::Unit& u, int wr, int wc, int fr, int fq) const {
        const int row0 = u.pm * 256 + wr * 64 + fr, col0 = u.pn * 256 + wc * 32 + 8 * fq, b = (u.pm * 256) / S;
        f32x4 gv[2][2];
#pragma unroll
        for (int bj = 0; bj < 2; ++bj)
#pragma unroll
            for (int n = 0; n < 2; ++n) gv[bj][n] = *(const f32x4*)(gm + (size_t)b * 6144 + col0 + bj * 128 + n * 4);
#pragma unroll
        for (int ai = 0; ai < 2; ++ai)
#pragma unroll
            for (int m = 0; m < 4; ++m) {
                const size_t off = (size_t)(row0 + ai * 128 + m * 16) * D + col0;
#pragma unroll
                for (int bj = 0; bj < 2; ++bj) {
                    f32x4 x0, x1;
                    if (xin32) { x0 = __builtin_nontemporal_load((const f32x4*)(xin32 + off + bj * 128)); x1 = __builtin_nontemporal_load((const f32x4*)(xin32 + off + bj * 128 + 4)); }
                    else { const u32x4 xv = __builtin_nontemporal_load((const u32x4*)(xin16 + off + bj * 128));
                        x0 = (f32x4){__uint_as_float(xv.x << 16), __uint_as_float(xv.x & 0xffff0000u), __uint_as_float(xv.y << 16), __uint_as_float(xv.y & 0xffff0000u)};
                        x1 = (f32x4){__uint_as_float(xv.z << 16), __uint_as_float(xv.z & 0xffff0000u), __uint_as_float(xv.w << 16), __uint_as_float(xv.w & 0xffff0000u)}; }
                    const f32x4 v0 = x0 + gv[bj][0] * acc[ai][bj][m][0], v1 = x1 + gv[bj][1] * acc[ai][bj][m][1];
                    u32x4 w; w.x = pg8::cvt_pk_bf16(v0[0], v0[1]); w.y = pg8::cvt_pk_bf16(v0[2], v0[3]); w.z = pg8::cvt_pk_bf16(v1[0], v1[1]); w.w = pg8::cvt_pk_bf16(v1[2], v1[3]);
                    *(u32x4*)(out + off + bj * 128) = w;
                }
            }
    }
};
struct EpiGU {
    static constexpr bool PERM = true;
    bf16_t* hid; const LAS int* seg;
    __device__ __forceinline__ void operator()(const f32x4 (&acc)[2][2][4][2], const pg8::Unit& u, int wr, int wc, int fr, int fq) const {
        bf16_t* base = hid + ((size_t)(seg[16 + u.e] + u.pm * 256 + wr * 64 + fr)) * DFF + u.pn * 128 + wc * 32 + 8 * fq;
#pragma unroll
        for (int ai = 0; ai < 2; ++ai)
#pragma unroll
            for (int m = 0; m < 4; ++m) {
                f32x4 h[2];
#pragma unroll
                for (int n = 0; n < 2; ++n)
#pragma unroll
                    for (int j = 0; j < 4; ++j) { const float gte = acc[ai][0][m][n][j]; h[n][j] = gte * __builtin_amdgcn_rcpf(1.f + __expf(-gte)) * acc[ai][1][m][n][j]; }
                u32x4 w; w.x = pg8::cvt_pk_bf16(h[0][0], h[0][1]); w.y = pg8::cvt_pk_bf16(h[0][2], h[0][3]); w.z = pg8::cvt_pk_bf16(h[1][0], h[1][1]); w.w = pg8::cvt_pk_bf16(h[1][2], h[1][3]);
                *(u32x4*)(base + (size_t)(ai * 128 + m * 16) * DFF) = w;
            }
    }
};
struct EpiDown {
    static constexpr bool PERM = true;
    bf16_t* yb; const int* list; const float* listw; const LAS int* seg; LAS unsigned char* ldsb;
    __device__ __forceinline__ void pre(LAS unsigned char* lds, const pg8::Unit& u, int tid) const {
        const int t = tid & 255, wv = __builtin_amdgcn_readfirstlane(tid >> 6);
        const void* src = tid < 256 ? (const void*)(list + u.e * NTOK + u.pm * 256 + t) : (const void*)(listw + u.e * NTOK + u.pm * 256 + t);
        lds_dma4(src, (unsigned)__builtin_amdgcn_readfirstlane((unsigned)(uintptr_t)lds + DNSL_OFF + u.par * 2048 + wv * 256));
    }
    __device__ __forceinline__ void operator()(const f32x4 (&acc)[2][2][4][2], const pg8::Unit& u, int wr, int wc, int fr, int fq) const {
        const int cnt = seg[u.e], col0 = u.pn * 256 + wc * 32 + 8 * fq;
        const LAS int* sl_e = (const LAS int*)(ldsb + DNSL_OFF + u.par * 2048); const LAS float* sl_g = (const LAS float*)(ldsb + DNSL_OFF + u.par * 2048 + 1024);
#pragma unroll
        for (int ai = 0; ai < 2; ++ai)
#pragma unroll
            for (int m = 0; m < 4; ++m) {
                const int ll = ai * 128 + wr * 64 + m * 16 + fr, lr = u.pm * 256 + ll;
                if (lr < cnt) {
                    const int ent = sl_e[ll]; const float gw = sl_g[ll];
                    bf16_t* rowp = yb + ((size_t)(ent & 1) * NTOK + (size_t)(ent >> 1)) * D + col0;
#pragma unroll
                    for (int bj = 0; bj < 2; ++bj) {
                        const f32x4 v0 = acc[ai][bj][m][0] * gw, v1 = acc[ai][bj][m][1] * gw;
                        u32x4 w; w.x = pg8::cvt_pk_bf16(v0[0], v0[1]); w.y = pg8::cvt_pk_bf16(v0[2], v0[3]); w.z = pg8::cvt_pk_bf16(v1[0], v1[1]); w.w = pg8::cvt_pk_bf16(v1[2], v1[3]);
                        *(u32x4*)(rowp + bj * 128) = w;
                    }
                }
            }
    }
};

struct PrepItem { const float* src; bf16_t* dst; int ldw, K; };
__device__ __forceinline__ PrepItem prep_decode(const Args& a, int l, int r) {
    constexpr int I_IN = 16 * 104, I_OUT = 16 * 32, I_GU = 16 * 16 * 32;
    PrepItem p;
    if (r < I_IN) {
        const int kb = r / 104, nb = r % 104, cp = nb * 32;
        const int lc = slot_col(4 * (cp >> 8) + ((cp >> 5) & 3)) + 32 * ((cp >> 7) & 1);
        p.src = a.in[I_WIN] + (size_t)l * D * IN_COLS + (size_t)kb * 64 * IN_COLS + lc; p.ldw = IN_COLS;
        p.dst = (bf16_t*)(a.ws + WS_WIN) + ((size_t)l * 3328 + cp) * D + kb * 64; p.K = D; return p;
    }
    r -= I_IN;
    if (r < I_OUT) {
        const int kb = r / 32, nb = r % 32;
        p.src = a.in[I_WOUT] + (size_t)l * D * D + (size_t)kb * 64 * D + nb * 32; p.ldw = D;
        p.dst = (bf16_t*)(a.ws + WS_WOUT) + ((size_t)l * D + nb * 32) * D + kb * 64; p.K = D; return p;
    }
    r -= I_OUT;
    if (r < I_GU) {
        const int e = r / 512, r2 = r % 512, kb = r2 / 32, nb = r2 % 32, pn = nb >> 3, bj = (nb >> 2) & 1, sub = nb & 3;
        p.src = a.in[bj ? I_WU : I_WG] + ((size_t)l * NE + e) * D * DFF + (size_t)kb * 64 * DFF + 128 * pn + 32 * sub; p.ldw = DFF;
        p.dst = (bf16_t*)(a.ws + WS_WGU) + (((size_t)l * NE + e) * 1024 + nb * 32) * D + kb * 64; p.K = D; return p;
    }
    r -= I_GU;
    { const int e = r / 256, r2 = r % 256, kb = r2 / 32, nb = r2 % 32;
      p.src = a.in[I_WD] + ((size_t)l * NE + e) * DFF * D + (size_t)kb * 64 * D + nb * 32; p.ldw = D;
      p.dst = (bf16_t*)(a.ws + WS_WDN) + (((size_t)l * NE + e) * 1024 + nb * 32) * DFF + kb * 64; p.K = DFF; return p; }
}
__device__ __forceinline__ void p0_prep(const Args& a, LAS unsigned char* lds, int l, int blk0, int nblk) {
    const int tid = opaque_tid(), lane = tid & 63, wave = tid >> 6;
    LAS float* scr = (LAS float*)(lds + 49152) + wave * (64 * 33);
    const int gw = ((int)blockIdx.x - blk0) * NWAVES + wave, ngw = nblk * NWAVES;
    constexpr int I_L = 16 * 104 + 16 * 32 + 16 * 16 * 32 + 16 * 8 * 32;
    if ((int)blockIdx.x < blk0 || (int)blockIdx.x >= blk0 + nblk) return;
    float tv[32];
    int it = gw;
    if (it < I_L) { const PrepItem p = prep_decode(a, l, it);
#pragma unroll
        for (int i = 0; i < 32; ++i) tv[i] = __builtin_nontemporal_load(p.src + (size_t)(2 * i + (lane >> 5)) * p.ldw + (lane & 31)); }
    for (; it < I_L; it += ngw) {
        const PrepItem p = prep_decode(a, l, it);
#pragma unroll
        for (int i = 0; i < 32; ++i) scr[(2 * i + (lane >> 5)) * 33 + (lane & 31)] = tv[i];
        if (it + ngw < I_L) { const PrepItem q = prep_decode(a, l, it + ngw);
#pragma unroll
            for (int i = 0; i < 32; ++i) tv[i] = __builtin_nontemporal_load(q.src + (size_t)(2 * i + (lane >> 5)) * q.ldw + (lane & 31)); }
        asm volatile("s_waitcnt lgkmcnt(0)" ::: "memory");
        const int c = lane & 7;
#pragma unroll
        for (int j = 0; j < 4; ++j) { const int n = (lane >> 3) + 8 * j; const LAS float* sp = scr + (8 * c) * 33 + n;
            u32x4 o; o.x = pk2(sp[0 * 33], sp[1 * 33]); o.y = pk2(sp[2 * 33], sp[3 * 33]); o.z = pk2(sp[4 * 33], sp[5 * 33]); o.w = pk2(sp[6 * 33], sp[7 * 33]);
            *(u32x4*)(p.dst + (size_t)n * p.K + 8 * c) = o; }
        asm volatile("s_waitcnt lgkmcnt(0)" ::: "memory");
    }
}

__device__ __forceinline__ void p0_mod(const Args& a, LAS unsigned char* lds) {
    LAS float* cs = (LAS float*)lds;
    LAS float* red = (LAS float*)(lds + 32768);
    const int tid = opaque_tid();
    const float* c = a.in[I_C];
    for (int i = tid; i < NB * D; i += NTHR) { const float v = c[i]; cs[i] = v / (1.f + expf(-v)); }
    __syncthreads();
    float* mod = (float*)(a.ws + WS_MOD);
    const int dch = tid >> 5, el = tid & 31;
    for (int u = blockIdx.x; u < NL * 192; u += gridDim.x) {
        const int l = u / 192, e0 = (u % 192) * 32;
        const float* w = a.in[I_ADAW] + (size_t)l * D * 6144 + e0 + el;
        float acc[8];
#pragma unroll
        for (int b = 0; b < 8; ++b) acc[b] = 0.f;
        for (int d = dch * 64; d < dch * 64 + 64; ++d) {
            const float wv = __builtin_nontemporal_load(w + (size_t)d * 6144);
#pragma unroll
            for (int b = 0; b < 8; ++b) acc[b] += cs[b * D + d] * wv;
        }
#pragma unroll
        for (int b = 0; b < 8; ++b) red[(dch * 32 + el) * 8 + b] = acc[b];
        __syncthreads();
        if (tid < 256) {
            const int e2 = tid & 31, b = tid >> 5; float s = 0.f;
            for (int k = 0; k < 16; ++k) s += red[(k * 32 + e2) * 8 + b];
            mod[((size_t)l * NB + b) * 6144 + e0 + e2] = s + a.in[I_ADAB][l * 6144 + e0 + e2];
        }
        __syncthreads();
    }
}

__device__ __forceinline__ f32x4 bf4_lo(const u32x4& v) { return (f32x4){__uint_as_float(v.x << 16), __uint_as_float(v.x & 0xffff0000u), __uint_as_float(v.y << 16), __uint_as_float(v.y & 0xffff0000u)}; }
__device__ __forceinline__ f32x4 bf4_hi(const u32x4& v) { return (f32x4){__uint_as_float(v.z << 16), __uint_as_float(v.z & 0xffff0000u), __uint_as_float(v.w << 16), __uint_as_float(v.w & 0xffff0000u)}; }
__device__ __forceinline__ void n1_norm(const Args& a, LAS unsigned char* lds, int layer, bool dry = false) {
    LAS float* wf = (LAS float*)lds;
    const int tid = opaque_tid(), lane = tid & 63, wave = tid >> 6;
    const float* win = a.in[I_WIN] + (size_t)layer * D * IN_COLS;
    for (int i = tid; i < D * 4; i += NTHR) wf[i] = win[(size_t)(i >> 2) * IN_COLS + 1024 + (i & 3)];
    __syncthreads();
    const float* mod = (const float*)(a.ws + WS_MOD);
    const float* nm = a.in[I_NMIX] + layer * D;
    bf16_t* act = (bf16_t*)(a.ws + WS_ACT);
    float* flog = (float*)(a.ws + WS_FLOG);
    const bf16_t* yb = (const bf16_t*)(a.ws + WS_YBUF);
    const int gw = blockIdx.x * NWAVES + wave, ngw = gridDim.x * NWAVES;
    for (int rg = gw; rg < NTOK / 16; rg += ngw) {
        const int row0 = rg * 16, b = row0 / S;
        const float* sh = mod + ((size_t)layer * NB + b) * 6144;
        const float* sc = sh + 1024;
        const float* gf = mod + ((size_t)(layer > 0 ? layer - 1 : 0) * NB + b) * 6144 + 5120;
        f32x4 ga[4], s0v[4], gfv[4];
#pragma unroll
        for (int j = 0; j < 4; ++j) { const int col = 8 * lane + 512 * (j >> 1) + 4 * (j & 1);
            ga[j] = *(const f32x4*)(nm + col) * (1.f + *(const f32x4*)(sc + col)); s0v[j] = *(const f32x4*)(sh + col); gfv[j] = *(const f32x4*)(gf + col); }
        f32x4 nx[4]; u32x4 nb[6];
#define N1_LOAD(r_) do { if (layer == 0) { const float* xin_ = a.in[I_X] + (size_t)(r_) * D; _Pragma("unroll") for (int j = 0; j < 4; ++j) nx[j] = __builtin_nontemporal_load((const f32x4*)(xin_ + 8 * lane + 512 * (j >> 1) + 4 * (j & 1))); } \
        else { _Pragma("unroll") for (int jp = 0; jp < 2; ++jp) { const size_t o_ = (size_t)(r_) * D + 8 * lane + 512 * jp; \
            nb[3 * jp] = __builtin_nontemporal_load((const u32x4*)((const bf16_t*)(a.ws + WS_XB) + o_)); nb[3 * jp + 1] = __builtin_nontemporal_load((const u32x4*)(yb + o_)); nb[3 * jp + 2] = __builtin_nontemporal_load((const u32x4*)(yb + (size_t)NTOK * D + o_)); } } } while (0)
        N1_LOAD(row0);
#pragma unroll 1
        for (int i = 0; i < 16; ++i) {
            const int row = row0 + i;
            f32x4 v[4];
            bf16_t* xb = (bf16_t*)(a.ws + WS_XB) + (size_t)row * D;
            if (layer == 0) {
#pragma unroll
                for (int j = 0; j < 4; ++j) v[j] = nx[j];
            } else {
#pragma unroll
                for (int jp = 0; jp < 2; ++jp) {
                    v[2 * jp] = bf4_lo(nb[3 * jp]) + gfv[2 * jp] * (bf4_lo(nb[3 * jp + 1]) + bf4_lo(nb[3 * jp + 2]));
                    v[2 * jp + 1] = bf4_hi(nb[3 * jp]) + gfv[2 * jp + 1] * (bf4_hi(nb[3 * jp + 1]) + bf4_hi(nb[3 * jp + 2]));
                }
            }
            if (i < 15) N1_LOAD(row + 1);
            if (layer > 0 && !dry) {
#pragma unroll
                for (int jp = 0; jp < 2; ++jp) { u32x4 xo; xo.x = pk2(v[2 * jp].x, v[2 * jp].y); xo.y = pk2(v[2 * jp].z, v[2 * jp].w); xo.z = pk2(v[2 * jp + 1].x, v[2 * jp + 1].y); xo.w = pk2(v[2 * jp + 1].z, v[2 * jp + 1].w);
                    *(u32x4*)(xb + 8 * lane + 512 * jp) = xo; }
            }
            float ss = 0.f;
#pragma unroll
            for (int j = 0; j < 4; ++j) ss += v[j].x * v[j].x + v[j].y * v[j].y + v[j].z * v[j].z + v[j].w * v[j].w;
            const float rstd = rsqrtf(wave_sum(ss) * (1.f / D) + RMS_EPS);
            float fl[4] = {0.f, 0.f, 0.f, 0.f};
#pragma unroll
            for (int jp = 0; jp < 2; ++jp) {
                f32x4 h[2];
#pragma unroll
                for (int k = 0; k < 2; ++k) {
                    const int col = 8 * lane + 512 * jp + 4 * k;
                    h[k] = v[2 * jp + k] * rstd * ga[2 * jp + k] + s0v[2 * jp + k];
#pragma unroll
                    for (int q = 0; q < 4; ++q) fl[q] += h[k].x * wf[(col + 0) * 4 + q] + h[k].y * wf[(col + 1) * 4 + q] + h[k].z * wf[(col + 2) * 4 + q] + h[k].w * wf[(col + 3) * 4 + q];
                }
                u32x4 o; o.x = pk2(h[0].x, h[0].y); o.y = pk2(h[0].z, h[0].w); o.z = pk2(h[1].x, h[1].y); o.w = pk2(h[1].z, h[1].w);
                *(u32x4*)(act + (size_t)row * D + 8 * lane + 512 * jp) = o;
            }
#pragma unroll
            for (int q = 0; q < 4; ++q) fl[q] = wave_sum(fl[q]);
            if (lane < 4) {
                const float f = lane == 0 ? fl[0] : lane == 1 ? fl[1] : lane == 2 ? fl[2] : fl[3];
                flog[(size_t)row * 4 + lane] = log_sigmoid_f(f + a.in[I_BFORGET][layer * 4 + lane]);
            }
        }
#undef N1_LOAD
    }
    __syncthreads();
}


__device__ __forceinline__ int t5_bucket(int dist) {
    if (dist < 16) return dist;
    int b = 16;
    b += dist >= 22; b += dist >= 30; b += dist >= 40; b += dist >= 54; b += dist >= 73; b += dist >= 99; b += dist >= 134; b += dist >= 182;
    b += dist >= 246; b += dist >= 332; b += dist >= 450; b += dist >= 609; b += dist >= 825; b += dist >= 1117; b += dist >= 1513;
    return b;
}


__device__ __forceinline__ void n2_glds16(const void* gsrc, unsigned lds_dst) { unsigned keep;
    asm volatile("s_mov_b32 %0, m0\n\ts_mov_b32 m0, %2\n\ts_nop 0\n\tglobal_load_lds_dwordx4 %1, off\n\ts_mov_b32 m0, %0" : "=&s"(keep) : "v"(gsrc), "s"(lds_dst) : "memory"); }
__device__ __forceinline__ void n2_mfma(const Args& a, LAS unsigned char* lds, int layer) {
    LAS float* WgL = (LAS float*)lds;
    LAS float* lgw = (LAS float*)(lds + 65536);
    LAS int* pe = (LAS int*)(lds + 73728);
    LAS float* pg = (LAS float*)(lds + 74752);
    LAS int* sbase = (LAS int*)(lds + 76800);
    LAS int* wtot = (LAS int*)(lds + 77056);
    LAS float* gaL = (LAS float*)(lds + 77824); LAS float* s0L = gaL + 1024;
    LAS float* ceL = (LAS float*)(lds + 86016);
    LAS float* cpart = (LAS float*)(lds + 86080);
    constexpr int N2_BUF = 89088;
    const int tid = opaque_tid(), wave = __builtin_amdgcn_readfirstlane(tid >> 6);
    const float* mod = (const float*)(a.ws + WS_MOD);
    const float* nf = a.in[I_NFFN] + layer * D;
    bf16_t* act = (bf16_t*)(a.ws + WS_ACT);
    unsigned* cnt = (unsigned*)(a.ws + WS_CTL) + CW_CNT + layer * 16 * 64;
    int* list = (int*)(a.ws + WS_LIST);
    float* listw = (float*)(a.ws + WS_LISTW);
    const unsigned l0 = (unsigned)(uintptr_t)lds;
    for (int rblk = blockIdx.x; rblk < NTOK / 128; rblk += gridDim.x) {
        const int row0 = rblk * 128 + wave * 16, b = (rblk * 128) / S;
        const float* sh = mod + ((size_t)layer * NB + b) * 6144 + 3072;
        const float* sc = sh + 1024;
        __syncthreads();
        int lane_ = tid & 63; asm volatile("" : "+v"(lane_));
        const int r = lane_ & 15, g = lane_ >> 4;
        const bf16_t* xbase = (const bf16_t*)(a.ws + WS_XB) + (size_t)row0 * D;
        const int dr0 = lane_ >> 3, dr1 = 8 + (lane_ >> 3);
        const bf16_t* src0 = xbase + (size_t)dr0 * D + 8 * ((lane_ & 7) ^ ((dr0 >> 1) & 7));
        const bf16_t* src1 = xbase + (size_t)dr1 * D + 8 * ((lane_ & 7) ^ ((dr1 >> 1) & 7));
        const unsigned bufw = l0 + N2_BUF + wave * 6144;
#define N2_DMA(c) do { const unsigned d_ = (unsigned)__builtin_amdgcn_readfirstlane(bufw + ((c) % 3) * 2048); n2_glds16(src0 + (c) * 64, d_); n2_glds16(src1 + (c) * 64, d_ + 1024); } while (0)
        N2_DMA(0); N2_DMA(1);
        for (int i = tid; i < D; i += NTHR) { gaL[i] = nf[i] * (1.f + sc[i]); s0L[i] = sh[i]; }
        __syncthreads();
        {
            int ts = tid; asm volatile("" : "+v"(ts));
            const int e = ts & 15, part = ts >> 4;
            float cs = 0.f;
#pragma unroll 16
            for (int t = 0; t < 32; ++t) {
                const int col = part * 32 + t;
                const float w = a.in[I_RW][col * 16 + e];
                const int c = col >> 6, p8 = (col >> 3) & 7, j = col & 7, g = p8 & 3, ii = p8 >> 2, q = 2 * ii + (j >> 2), jj = j & 3;
                WgL[(((c * 4 + g) * 4 + q) * 16 + e) * 4 + jj] = w * gaL[col];
                cs += w * s0L[col];
            }
            cpart[part * 16 + e] = cs;
        }
        __syncthreads();
        if (tid < 16) { float t = 0.f; for (int k = 0; k < 32; ++k) t += cpart[k * 16 + tid]; ceL[tid] = t; }
        __syncthreads();
        const LAS unsigned char* rdb = lds + N2_BUF + wave * 6144 + r * 128;
        const int sw = (r >> 1) & 7;
        const int sl0 = 16 * (g ^ sw), sl1 = 16 * ((g + 4) ^ sw);
        u32x4 xs[32];
        f32x4 acc0 = (f32x4){0.f, 0.f, 0.f, 0.f}, acc1 = (f32x4){0.f, 0.f, 0.f, 0.f};
        float ss = 0.f;
#pragma unroll
        for (int c = 0; c < 16; ++c) {
            asm volatile("s_waitcnt lgkmcnt(0)" ::: "memory");
            if (c + 2 < 16) { N2_DMA(c + 2); asm volatile("s_waitcnt vmcnt(4)" ::: "memory"); }
            else if (c + 1 < 16) asm volatile("s_waitcnt vmcnt(2)" ::: "memory");
            else asm volatile("s_waitcnt vmcnt(0)" ::: "memory");
            const LAS unsigned char* cb = rdb + (c % 3) * 2048;
            xs[2 * c] = *(const LAS u32x4*)(cb + sl0);
            xs[2 * c + 1] = *(const LAS u32x4*)(cb + sl1);
            const LAS f32x4* wq = (const LAS f32x4*)(WgL + ((c * 4) * 4 * 16) * 4) + (g * 4) * 16 + r;
            f32x4 w0 = wq[0], w1 = wq[16], w2 = wq[32], w3 = wq[48];
#pragma unroll
            for (int k = 0; k < 4; ++k) {
                const unsigned v0 = xs[2 * c][k], v1 = xs[2 * c + 1][k];
                const float x00 = __uint_as_float(v0 << 16), x01 = __uint_as_float(v0 & 0xffff0000u);
                const float x10 = __uint_as_float(v1 << 16), x11 = __uint_as_float(v1 & 0xffff0000u);
                ss += x00 * x00 + x01 * x01; ss += x10 * x10 + x11 * x11;
                const float wa = (k < 2 ? w0 : w1)[2 * (k & 1)], wb = (k < 2 ? w0 : w1)[2 * (k & 1) + 1];
                const float wc = (k < 2 ? w2 : w3)[2 * (k & 1)], wd = (k < 2 ? w2 : w3)[2 * (k & 1) + 1];
                acc0 = __builtin_amdgcn_mfma_f32_16x16x4f32(wa, x00, acc0, 0, 0, 0);
                acc1 = __builtin_amdgcn_mfma_f32_16x16x4f32(wc, x10, acc1, 0, 0, 0);
                acc0 = __builtin_amdgcn_mfma_f32_16x16x4f32(wb, x01, acc0, 0, 0, 0);
                acc1 = __builtin_amdgcn_mfma_f32_16x16x4f32(wd, x11, acc1, 0, 0, 0);
            }
            __builtin_amdgcn_sched_barrier(0);
        }
#undef N2_DMA
        ss += __shfl_xor(ss, 16); ss += __shfl_xor(ss, 32);
        const float rstd = rsqrtf(ss * (1.f / D) + RMS_EPS);
#pragma unroll
        for (int i = 0; i < 32; ++i) asm volatile("" : "+v"(xs[i]));
        int lane_b = tid & 63; asm volatile("" : "+v"(lane_b));
        const int rb_ = lane_b & 15, gb_ = lane_b >> 4;
        {
            const f32x4 ce4 = *(const LAS f32x4*)(ceL + 4 * gb_);
            *(LAS f32x4*)(lgw + (wave * 16 + rb_) * 16 + 4 * gb_) = (acc0 + acc1) * rstd + ce4;
        }
        bf16_t* arow = act + (size_t)(row0 + rb_) * D + 8 * gb_;
#pragma unroll
        for (int c = 0; c < 16; ++c)
#pragma unroll
            for (int i = 0; i < 2; ++i) {
                const int col0 = 64 * c + 32 * i;
                const LAS f32x4* gp = (const LAS f32x4*)(gaL + col0) + 2 * gb_; const LAS f32x4* sp = (const LAS f32x4*)(s0L + col0) + 2 * gb_;
                const f32x4 ga0 = gp[0] * rstd, ga1 = gp[1] * rstd, s00 = sp[0], s01 = sp[1];
                const u32x4 xv = xs[2 * c + i];
                const f32x4 h0 = bf4_lo(xv) * ga0 + s00, h1 = bf4_hi(xv) * ga1 + s01;
                u32x4 o; o.x = pk2(h0.x, h0.y); o.y = pk2(h0.z, h0.w); o.z = pk2(h1.x, h1.y); o.w = pk2(h1.z, h1.w);
                *(u32x4*)(arow + col0) = o;
                __builtin_amdgcn_sched_barrier(0);
            }
        asm volatile("s_waitcnt lgkmcnt(0)" ::: "memory");
        int lane_c = tid & 63; asm volatile("" : "+v"(lane_c));
        if (lane_c < 16) {
            const int lane = lane_c;
            float lg[16];
#pragma unroll
            for (int q = 0; q < 4; ++q) { const f32x4 t4 = *(const LAS f32x4*)(lgw + (wave * 16 + lane) * 16 + 4 * q); const f32x4 rb4 = *(const f32x4*)(a.in[I_RB] + 4 * q);
                lg[4 * q] = t4.x + rb4.x; lg[4 * q + 1] = t4.y + rb4.y; lg[4 * q + 2] = t4.z + rb4.z; lg[4 * q + 3] = t4.w + rb4.w; }
            float mx = lg[0];
#pragma unroll
            for (int e = 1; e < 16; ++e) mx = fmaxf(mx, lg[e]);
            float p[16], sum = 0.f;
#pragma unroll
            for (int e = 0; e < 16; ++e) { p[e] = expf(lg[e] - mx); sum += p[e]; }
            const float inv = 1.f / sum;
#pragma unroll
            for (int e = 0; e < 16; ++e) p[e] *= inv;
            int bg = 0, bi0 = 0, bi1 = 1; float bscore = -1.f, bp0 = 0.f, bp1 = 0.f;
#pragma unroll
            for (int gq = 0; gq < 4; ++gq) {
                int i0 = 0; float p0 = p[4 * gq];
#pragma unroll
                for (int k = 1; k < 4; ++k) if (p[4 * gq + k] > p0) { p0 = p[4 * gq + k]; i0 = k; }
                int i1 = -1; float p1 = -1.f;
#pragma unroll
                for (int k = 0; k < 4; ++k) if (k != i0 && p[4 * gq + k] > p1) { p1 = p[4 * gq + k]; i1 = k; }
                const float sc2 = p0 + p1;
                if (sc2 > bscore) { bscore = sc2; bg = gq; bi0 = i0; bi1 = i1; bp0 = p0; bp1 = p1; }
            }
            const float gs = 1.f / (bp0 + bp1);
            const int pi = (wave * 16 + lane) * 2;
            pe[pi] = bg * 4 + bi0; pg[pi] = bp0 * gs; pe[pi + 1] = bg * 4 + bi1; pg[pi + 1] = bp1 * gs;
        }
        __syncthreads();
        int my_e = 0, my_rank = 0;
        int tq = tid; asm volatile("" : "+v"(tq));
        if (tq < 256) {
            my_e = pe[tq];
#pragma unroll
            for (int e = 0; e < 16; ++e) {
                const unsigned long long m = __ballot(my_e == e);
                if (my_e == e) my_rank = __popcll(m & ((1ull << (tq & 63)) - 1ull));
                if ((tq & 63) == 0) wtot[(tq >> 6) * 16 + e] = __popcll(m);
            }
        }
        __syncthreads();
        if (tq < 16) {
            const int c0 = wtot[tq], c1 = wtot[16 + tq], c2 = wtot[32 + tq], c3 = wtot[48 + tq], c = c0 + c1 + c2 + c3;
            const int base = c ? (int)__hip_atomic_fetch_add(cnt + tq * 64, (unsigned)c, __ATOMIC_RELAXED, __HIP_MEMORY_SCOPE_AGENT) : 0;
            sbase[tq] = base; sbase[16 + tq] = base + c0; sbase[32 + tq] = base + c0 + c1; sbase[48 + tq] = base + c0 + c1 + c2;
        }
        __syncthreads();
        if (tq < 256) {
            const int pos = sbase[(tq >> 6) * 16 + my_e] + my_rank;
            list[my_e * NTOK + pos] = (rblk * 128 + (tq >> 1)) * 2 + (tq & 1); listw[my_e * NTOK + pos] = pg[tq];
        }
        __syncthreads();
    }
}

__device__ __forceinline__ void fin_combine(const Args& a, int layer, float* outp = nullptr) {
    const float* mod = (const float*)(a.ws + WS_MOD);
    const bf16_t* yb = (const bf16_t*)(a.ws + WS_YBUF);
    const bf16_t* xb = (const bf16_t*)(a.ws + WS_XB);
    float* out = outp ? outp : a.out;
    const size_t n8 = (size_t)NTOK * D / 8;
    for (size_t i = (size_t)blockIdx.x * NTHR + threadIdx.x; i < n8; i += (size_t)gridDim.x * NTHR) {
        const size_t e0 = i * 8; const int row = (int)(e0 / D), col = (int)(e0 % D), b = row / S;
        const u32x4 xv = __builtin_nontemporal_load((const u32x4*)(xb + e0)), y0 = __builtin_nontemporal_load((const u32x4*)(yb + e0)), y1 = __builtin_nontemporal_load((const u32x4*)(yb + (size_t)NTOK * D + e0));
        const float* gp = mod + ((size_t)layer * NB + b) * 6144 + 5120 + col;
        const f32x4 g0 = *(const f32x4*)gp, g1 = *(const f32x4*)(gp + 4);
        __builtin_nontemporal_store(bf4_lo(xv) + g0 * (bf4_lo(y0) + bf4_lo(y1)), (f32x4*)(out + e0));
        __builtin_nontemporal_store(bf4_hi(xv) + g1 * (bf4_hi(y0) + bf4_hi(y1)), (f32x4*)(out + e0 + 4));
    }
}


namespace att {
typedef short bf16x8 __attribute__((ext_vector_type(8)));
typedef short s16x4 __attribute__((ext_vector_type(4)));
typedef float f32x16 __attribute__((ext_vector_type(16)));
constexpr int L_K = 0, L_V = 49152, L_OST = 98304, L_CK = 135168, L_FLAG = 136192, L_INFO = 136448, L_TAB = 136704;
constexpr int OST_PITCH = 144;
__device__ __forceinline__ int crow(int r, int hi) { return (r & 3) + 8 * (r >> 2) + 4 * hi; }
typedef float f32x2_t __attribute__((ext_vector_type(2))); typedef __bf16 bf16x2_t __attribute__((ext_vector_type(2)));
__device__ __forceinline__ unsigned cvtpk(float lo, float hi) { f32x2_t v = {lo, hi}; bf16x2_t b = __builtin_convertvector(v, bf16x2_t); return __builtin_bit_cast(unsigned, b); }
__device__ __forceinline__ float other_half_sum(float v) {
    auto rr = __builtin_amdgcn_permlane32_swap(__float_as_uint(v), __float_as_uint(v), false, false);
    return __uint_as_float(rr[0]) + __uint_as_float(rr[1]);
}
__device__ __forceinline__ float other_half_max(float v) {
    auto rr = __builtin_amdgcn_permlane32_swap(__float_as_uint(v), __float_as_uint(v), false, false);
    return fmaxf(__uint_as_float(rr[0]), __uint_as_float(rr[1]));
}
__device__ __forceinline__ void glds16(const void* gsrc, unsigned lds_dst) { unsigned keep;
    asm volatile("s_mov_b32 %0, m0\n\ts_mov_b32 m0, %2\n\ts_nop 0\n\tglobal_load_lds_dwordx4 %1, off\n\ts_mov_b32 m0, %0" : "=&s"(keep) : "v"(gsrc), "s"(lds_dst) : "memory"); }
__device__ __forceinline__ void glds4(const void* gsrc, unsigned lds_dst) { unsigned keep;
    asm volatile("s_mov_b32 %0, m0\n\ts_mov_b32 m0, %2\n\ts_nop 0\n\tglobal_load_lds_dword %1, off\n\ts_mov_b32 m0, %0" : "=&s"(keep) : "v"(gsrc), "s"(lds_dst) : "memory"); }
__device__ __forceinline__ void dma_kv(LAS unsigned char* lds, int buf, const bf16_t* Kt, const bf16_t* Vt, size_t rowstride, int wid, int lane) {
    const int krow = 8 * wid + (lane >> 3), kch = (lane & 7) ^ ((krow >> 1) & 7);
    const bf16_t* ks = Kt + (size_t)krow * rowstride + kch * 8;
    const bf16_t* vs = Vt + (size_t)(16 * (wid & 3) + (lane >> 2)) * rowstride + (wid >> 2) * 32 + (lane & 3) * 8;
    const unsigned l0 = (unsigned)(uintptr_t)lds;
    glds16(ks, (unsigned)__builtin_amdgcn_readfirstlane(l0 + L_K + buf * 8192 + wid * 1024));
    glds16(vs, (unsigned)__builtin_amdgcn_readfirstlane(l0 + L_V + buf * 8192 + wid * 1024));
}
__device__ __forceinline__ void qkt(f32x16& p0, f32x16& p1, const LAS unsigned char* Kb, const bf16x8 (&qr)[4], float cinit, int r32, int hi) {
    const int sw = (r32 >> 1) & 7;
    bf16x8 kf[8];
#pragma unroll
    for (int d0 = 0; d0 < 4; ++d0) {
        unsigned ka = (unsigned)(uintptr_t)Kb + r32 * 128 + (((2 * d0 + hi) ^ sw) << 4); asm volatile("" : "+v"(ka));
        kf[2 * d0] = *(const LAS bf16x8*)(uintptr_t)ka;
        kf[2 * d0 + 1] = *(const LAS bf16x8*)(uintptr_t)(ka + 4096);
    }
#pragma unroll
    for (int r = 0; r < 16; ++r) { p0[r] = cinit; p1[r] = cinit; }
    __builtin_amdgcn_sched_barrier(0);
#pragma unroll
    for (int d0 = 0; d0 < 4; ++d0) {
        p0 = __builtin_amdgcn_mfma_f32_32x32x16_bf16(kf[2 * d0], qr[d0], p0, 0, 0, 0);
        p1 = __builtin_amdgcn_mfma_f32_32x32x16_bf16(kf[2 * d0 + 1], qr[d0], p1, 0, 0, 0);
    }
}
typedef short v4i16_t __attribute__((ext_vector_type(4)));
__device__ __forceinline__ s16x4 vtr(const LAS unsigned char* p) { return __builtin_bit_cast(s16x4, __builtin_amdgcn_ds_read_tr16_b64_v4i16((LAS v4i16_t*)p)); }
__device__ __forceinline__ void pv(f32x16 (&o)[2], const f32x16& p0, const f32x16& p1, const LAS unsigned char* Vb, int lane) {
    const int hi = lane >> 5;
    unsigned va = (unsigned)(uintptr_t)Vb + ((lane >> 4) & 1) * 32 + (lane & 3) * 8 + (4 * hi + ((lane & 15) >> 2)) * 64; asm volatile("" : "+v"(va));
    const LAS unsigned char* vp = (const LAS unsigned char*)(uintptr_t)va;
    s16x4 vlo[8], vhh[8];
#pragma unroll
    for (int i = 0; i < 8; ++i) { vlo[i] = vtr(vp + (i >> 2) * 4096 + (i & 3) * 1024); vhh[i] = vtr(vp + (i >> 2) * 4096 + (i & 3) * 1024 + 512); }
    u32x4 pw[4];
    pw[0] = (u32x4){cvtpk(p0[0], p0[1]), cvtpk(p0[2], p0[3]), cvtpk(p0[4], p0[5]), cvtpk(p0[6], p0[7])};
    pw[1] = (u32x4){cvtpk(p0[8], p0[9]), cvtpk(p0[10], p0[11]), cvtpk(p0[12], p0[13]), cvtpk(p0[14], p0[15])};
    pw[2] = (u32x4){cvtpk(p1[0], p1[1]), cvtpk(p1[2], p1[3]), cvtpk(p1[4], p1[5]), cvtpk(p1[6], p1[7])};
    pw[3] = (u32x4){cvtpk(p1[8], p1[9]), cvtpk(p1[10], p1[11]), cvtpk(p1[12], p1[13]), cvtpk(p1[14], p1[15])};
    __builtin_amdgcn_sched_barrier(0);
#pragma unroll
    for (int d0 = 0; d0 < 2; ++d0)
#pragma unroll
        for (int ks = 0; ks < 4; ++ks) {
            const s16x4 lo = vlo[4 * d0 + ks], hh = vhh[4 * d0 + ks];
            const bf16x8 vf = (bf16x8){lo[0], lo[1], lo[2], lo[3], hh[0], hh[1], hh[2], hh[3]};
            o[d0] = __builtin_amdgcn_mfma_f32_32x32x16_bf16(vf, __builtin_bit_cast(bf16x8, pw[ks]), o[d0], 0, 0, 0);
        }
}
__device__ __forceinline__ void exp_sum(f32x16& p0, f32x16& p1, float& l_part) {
    float rs = 0.f;
#pragma unroll
    for (int r = 0; r < 16; ++r) { p0[r] = __builtin_amdgcn_exp2f(p0[r]); p1[r] = __builtin_amdgcn_exp2f(p1[r]); rs += p0[r] + p1[r]; }
    l_part += rs;
}
__device__ __forceinline__ void online_step(f32x16& p0, f32x16& p1, float& m_run, float& l_part, f32x16 (&o)[2]) {
    float mt = fmaxf(p0[0], p1[0]);
#pragma unroll
    for (int r = 1; r < 16; ++r) mt = fmaxf(mt, fmaxf(p0[r], p1[r]));
    mt = other_half_max(mt);
    const float mn = fmaxf(m_run, mt);
    const float msafe = mn == -INFINITY ? 0.f : mn;
    const float f = __builtin_amdgcn_exp2f(m_run - msafe);
    float rs = 0.f;
#pragma unroll
    for (int r = 0; r < 16; ++r) { p0[r] = __builtin_amdgcn_exp2f(p0[r] - msafe); p1[r] = __builtin_amdgcn_exp2f(p1[r] - msafe); rs += p0[r] + p1[r]; }
    l_part = l_part * f + rs; m_run = mn;
#pragma unroll
    for (int r = 0; r < 16; ++r) { o[0][r] *= f; o[1][r] *= f; }
}
template <class RowPtr, class GatePtr>
__device__ __forceinline__ void store_o(const f32x16 (&o)[2], float scale, LAS unsigned char* lds, int wid, int lane, const RowPtr& rowp, const GatePtr& gatep, bool has_gate) {
    const int r32 = lane & 31, hi = lane >> 5;
    LAS unsigned char* stg = lds + L_OST + wid * (32 * OST_PITCH);
    u32x4 gv[4];
    if (has_gate) {
#pragma unroll
        for (int i = 0; i < 4; ++i) gv[i] = *(const u32x4*)(gatep(i * 8 + (lane >> 3)) + (lane & 7) * 8);
    }
#pragma unroll
    for (int d0 = 0; d0 < 2; ++d0)
#pragma unroll
        for (int g = 0; g < 4; ++g) {
            u32x2 w; w.x = cvtpk(o[d0][4 * g] * scale, o[d0][4 * g + 1] * scale); w.y = cvtpk(o[d0][4 * g + 2] * scale, o[d0][4 * g + 3] * scale);
            *(LAS u32x2*)(stg + r32 * OST_PITCH + (32 * d0 + 8 * g + 4 * hi) * 2) = w;
        }
    asm volatile("s_waitcnt lgkmcnt(0)" ::: "memory");
#pragma unroll
    for (int i = 0; i < 4; ++i) {
        const int row = i * 8 + (lane >> 3), ch = lane & 7;
        u32x4 v = *(const LAS u32x4*)(stg + row * OST_PITCH + ch * 16);
        if (has_gate) {
#pragma unroll
            for (int k = 0; k < 4; ++k) {
                const float a0 = __uint_as_float(v[k] << 16) * __uint_as_float(gv[i][k] << 16), a1 = __uint_as_float(v[k] & 0xffff0000u) * __uint_as_float(gv[i][k] & 0xffff0000u);
                v[k] = cvtpk(a0, a1);
            }
        }
        *(u32x4*)(rowp(row) + ch * 8) = v;
    }
    asm volatile("s_waitcnt lgkmcnt(0)" ::: "memory");
}
}

constexpr int AT_NFOX = 512, AT_NDIL = 2304, AT_NSB = 768, AT_NUNITS = AT_NFOX + AT_NDIL + AT_NSB;
#define AT_DIL_SPLIT 1
constexpr int CW_QUEUE = 20480;

__device__ __forceinline__ void at_mfma(const Args& a, LAS unsigned char* lds, int layer, int qslot = 0, int kmask = 7, int dbg = 0) {
    using namespace att;
    const int tid = opaque_tid(), wid = __builtin_amdgcn_readfirstlane(tid >> 6);
    const bf16_t* proj = (const bf16_t*)(a.ws + WS_PROJ);
    bf16_t* mix = (bf16_t*)(a.ws + WS_ACT);
    bf16_t* dilo = (bf16_t*)a.out;
    float* dill = (float*)(a.ws + WS_DILL);
    const float* cumall = (const float*)(a.ws + WS_CUM);
    unsigned* queue = (unsigned*)(a.ws + WS_CTL) + CW_QUEUE + (layer + 2 * qslot) * 64;
    LAS int* flags = (LAS int*)(lds + L_FLAG);
    LAS int* info = (LAS int*)(lds + L_INFO);
    LAS float* tab = (LAS float*)(lds + L_TAB);
    LAS float* relb = (LAS float*)(lds + SEG_OFF + 256);
    if (tid < 32 * 6) relb[tid] = a.in[I_RELB][tid] * LOG2E;
    __syncthreads();
    float bfox, bdil, bmax;
    { const int l64 = tid & 63;
      float g0 = fabsf(a.in[I_QGF][layer * 64 + l64]), g1 = fabsf(a.in[I_KGF][layer * 64 + l64]), g2 = fabsf(a.in[I_QGD][layer * 64 + l64]), g3 = fabsf(a.in[I_KGD][layer * 64 + l64]);
      float rbm = 0.f;
      for (int i = l64; i < 32 * 6; i += 64) rbm = fmaxf(rbm, a.in[I_RELB][i]);
#pragma unroll
      for (int o2 = 1; o2 < 64; o2 <<= 1) { g0 = fmaxf(g0, __shfl_xor(g0, o2)); g1 = fmaxf(g1, __shfl_xor(g1, o2)); g2 = fmaxf(g2, __shfl_xor(g2, o2)); g3 = fmaxf(g3, __shfl_xor(g3, o2)); rbm = fmaxf(rbm, __shfl_xor(rbm, o2)); }
      bfox = 8.f * g0 * g1 * LOG2E * 1.01f; bdil = 8.f * g2 * g3 * LOG2E * 1.01f; bmax = fmaxf(rbm, 0.f) * LOG2E; }
    const float fox_thr = 152.f + 2.f * bfox;
    const bool fox_fixed = bfox < 40.f, dil_fixed = (bdil + bmax) < 40.f;
    const float m_dil = bdil + bmax;
    const unsigned l0 = (unsigned)(uintptr_t)lds;
#define AT_WAIT_BAR(NI, n) do { if ((n) >= 2) asm volatile("s_waitcnt vmcnt(%0) lgkmcnt(0)\n\ts_barrier" :: "n"(2 * (NI)) : "memory"); \
        else if ((n) == 1) asm volatile("s_waitcnt vmcnt(%0) lgkmcnt(0)\n\ts_barrier" :: "n"(NI) : "memory"); \
        else asm volatile("s_waitcnt vmcnt(0) lgkmcnt(0)\n\ts_barrier" ::: "memory"); } while (0)
#define FOX_ISSUE(i) do { const int j_ = jhi - (i), bf_ = (i) & 3; dma_kv(lds, bf_, Kb + (size_t)j_ * 4096, Vb + (size_t)j_ * 4096, 64, wid, lane); \
        glds4(cum + j_ * 64 + lane, (unsigned)__builtin_amdgcn_readfirstlane(l0 + L_CK + bf_ * 256)); } while (0)
#define SB_ISSUE(i) do { const int j_ = jhi - (i); dma_kv(lds, (i) & 3, Kb + (size_t)j_ * 4096, Vb + (size_t)j_ * 4096, 64, wid, lane); } while (0)
#define UNIT_ON(u_) ((u_) < AT_NFOX ? (MF_FOX && (kmask & 1)) : (u_) < AT_NFOX + AT_NDIL ? (MF_DIL && (kmask & 2)) : (MF_SB && (kmask & 4)))

    bf16x8 qr[4];
    auto prologue = [&](int u) {
        if (!UNIT_ON(u)) return;
        int lane = tid & 63; asm volatile("" : "+v"(lane));
        const int r32 = lane & 31, hi = lane >> 5;
        if (u < AT_NFOX) {
            const int qb = 15 - (u >> 5), bh = u & 31, b = bh >> 2, h = bh & 3, q0 = qb * 256;
            const size_t rb = (size_t)b * S;
            const bf16_t* Kb = proj + ((size_t)(4 + h) * NTOK + rb) * 64;
            const bf16_t* Vb = proj + ((size_t)(8 + h) * NTOK + rb) * 64;
            const float* cum = cumall + (size_t)bh * S;
            const int jhi = 4 * qb + 3;
            if (!(dbg & 1)) { FOX_ISSUE(0); FOX_ISSUE(1); FOX_ISSUE(2); }
            if (wid == 0) {
                const float cref = cum[q0];
                const bool dead = (lane <= jhi) && ((cref - cum[64 * lane + 63]) * LOG2E < -fox_thr);
                const unsigned long long bal = __ballot(dead);
                if (lane == 0) info[0] = __popcll(bal);
            }
            const bf16_t* Q = proj + ((size_t)(0 + h) * NTOK + rb + q0 + 32 * wid + r32) * 64;
#pragma unroll
            for (int d0 = 0; d0 < 4; ++d0) qr[d0] = *(const bf16x8*)(Q + d0 * 16 + hi * 8);
        } else if (u < AT_NFOX + AT_NDIL) {
            const int v2 = u - AT_NFOX, bh = v2 % 48, rest = v2 / 48, b = bh / 6, h = bh % 6, p = rest >> 4, x = rest & 15;
            const int dil = p == 0 ? 1 : p == 1 ? 4 : 16, res = x % dil, nb2 = x / dil;
            const size_t rb = (size_t)b * S;
            const bf16_t* Kb = proj + ((size_t)(22 + h) * NTOK + rb) * 64;
            const bf16_t* Vb = proj + ((size_t)(28 + h) * NTOK + rb) * 64;
            const int mk_base = 256 * nb2 - 128, tt_lo = nb2 == 0 ? 2 : 0;
            const size_t rs = (size_t)64 * dil;
#pragma unroll
            for (int tt = 5; tt >= 0; --tt) if (tt >= tt_lo && !(dbg & 1)) dma_kv(lds, tt, Kb + ((size_t)(mk_base + 64 * tt) * dil + res) * 64, Vb + ((size_t)(mk_base + 64 * tt) * dil + res) * 64, rs, wid, lane);
            if (tid < 256) { const int st = tid - 64; tab[tid] = (st >= 0 && st <= 128) ? relb[t5_bucket(st * dil) * 6 + h] : -INFINITY; }
            const size_t trow = (size_t)(256 * nb2 + 32 * wid + r32) * dil + res;
            const bf16_t* Q = proj + ((size_t)(16 + h) * NTOK + rb + trow) * 64;
#pragma unroll
            for (int d0 = 0; d0 < 4; ++d0) qr[d0] = *(const bf16x8*)(Q + d0 * 16 + hi * 8);
        } else {
            const int v2 = u - AT_NFOX - AT_NDIL, qb = 15 - v2 / 48, bh = v2 % 48, b = bh / 6, h = bh % 6, q0 = qb * 256;
            const size_t rb = (size_t)b * S;
            const bf16_t* Kb = proj + ((size_t)(40 + h) * NTOK + rb) * 64;
            const bf16_t* Vb = proj + ((size_t)(46 + h) * NTOK + rb) * 64;
            const int jhi = (q0 + 254) >> 6;
            if (!(dbg & 1)) { SB_ISSUE(0); SB_ISSUE(1); SB_ISSUE(2); }
            const bf16_t* Q = proj + ((size_t)(34 + h) * NTOK + rb + q0 + 32 * wid + r32) * 64;
#pragma unroll
            for (int d0 = 0; d0 < 4; ++d0) qr[d0] = *(const bf16x8*)(Q + d0 * 16 + hi * 8);
        }
    };

#define AT_QMAP(q_) ((q_) < AT_NFOX ? (q_) : (q_) + (AT_DIL_SPLIT ? AT_NDIL : 0))
    int u = AT_QMAP((int)blockIdx.x);
    if (u < AT_NUNITS) prologue(u);
    bool prev_st = false;
    while (u < AT_NUNITS) {
        if (prev_st) asm volatile("s_waitcnt vmcnt(4) lgkmcnt(0)\n\ts_barrier" ::: "memory");
        else asm volatile("s_waitcnt vmcnt(0) lgkmcnt(0)\n\ts_barrier" ::: "memory");
        int lane_ = tid & 63; asm volatile("" : "+v"(lane_));
        const int lane = lane_, r32 = lane & 31, hi = lane >> 5;
        asm volatile("" : "+v"(qr[0]), "+v"(qr[1]), "+v"(qr[2]), "+v"(qr[3]));
        unsigned nextu = 0;
        if (tid == 0) nextu = __hip_atomic_fetch_add(queue, 1u, __ATOMIC_RELAXED, __HIP_MEMORY_SCOPE_AGENT) + gridDim.x;
        f32x16 o[2]; o[0] = (f32x16){}; o[1] = (f32x16){};
        const bool on = UNIT_ON(u);
        float oscale = 1.f, lse = 0.f;
        if (on && !(dbg & 2)) {
        if (u < AT_NFOX) {
            const int qb = 15 - (u >> 5), bh = u & 31, b = bh >> 2, h = bh & 3, q0 = qb * 256;
            const size_t rb = (size_t)b * S;
            const bf16_t* Kb = proj + ((size_t)(4 + h) * NTOK + rb) * 64;
            const bf16_t* Vb = proj + ((size_t)(8 + h) * NTOK + rb) * 64;
            const float* cum = cumall + (size_t)bh * S;
            const int jhi = 4 * qb + 3;
            const int tw = q0 + 32 * wid, t = tw + r32;
            const int jhi_w = (tw + 31) >> 6;
            const int T = jhi - info[0] + 1;
            const float cinit = fox_fixed ? cum[t] * LOG2E - bfox : 0.f;
            float m_run = -INFINITY, l_part = 0.f;
            int issued = 3;
            for (int i = 0; i < T; ++i) {
                if (i > 0) { const int n = issued - 1 - i; AT_WAIT_BAR(3, n); }
                if (issued < T) { FOX_ISSUE(issued); ++issued; }
                const int j = jhi - i, buf = i & 3;
                if (j <= jhi_w) {
                    f32x16 p0, p1;
                    qkt(p0, p1, lds + L_K + buf * 8192, qr, cinit, r32, hi);
                    const LAS float* ck = (const LAS float*)(lds + L_CK + buf * 256);
                    const bool diag = (64 * j + 63 > tw);
#define FOX_BIAS(MASKED) _Pragma("unroll") for (int g = 0; g < 4; ++g) { \
                        const f32x4 c0 = *(const LAS f32x4*)(ck + 8 * g + 4 * hi), c1 = *(const LAS f32x4*)(ck + 32 + 8 * g + 4 * hi); \
                        _Pragma("unroll") for (int jj = 0; jj < 4; ++jj) { const int r = 4 * g + jj, s0 = 64 * j + crow(r, hi); \
                            p0[r] = fmaf(c0[jj], -LOG2E, p0[r]); p1[r] = fmaf(c1[jj], -LOG2E, p1[r]); \
                            if (MASKED) { if (s0 > t) p0[r] = -INFINITY; if (s0 + 32 > t) p1[r] = -INFINITY; } } }
                    if (diag) { asm volatile("; forgetting attention: diagonal tile (masked)" ::: "memory"); FOX_BIAS(true) } else { FOX_BIAS(false) }
#undef FOX_BIAS
                    if (fox_fixed) exp_sum(p0, p1, l_part); else online_step(p0, p1, m_run, l_part, o);
                    pv(o, p0, p1, lds + L_V + buf * 8192, lane);
                }
            }
            oscale = 1.f / other_half_sum(l_part);
        } else if (u < AT_NFOX + AT_NDIL) {
            const int v2 = u - AT_NFOX, rest = v2 / 48, x = rest & 15, p = rest >> 4;
            const int dil = p == 0 ? 1 : p == 1 ? 4 : 16, nb2 = x / dil;
            const int tt_lo = nb2 == 0 ? 2 : 0;
            const int twlo = wid >> 1;
            const float cinit = dil_fixed ? -m_dil : 0.f;
            float m_run = -INFINITY, l_part = 0.f;
#pragma unroll 1
            for (int tt = twlo + 2; tt >= twlo; --tt) {
                if (tt < tt_lo) break;
                f32x16 p0, p1;
                qkt(p0, p1, lds + L_K + tt * 8192, qr, cinit, r32, hi);
                const LAS float* tb = tab + (32 * wid + r32 + 192 - 64 * tt - 4 * hi - 63);
#pragma unroll
                for (int r = 0; r < 16; ++r) { p0[r] += tb[63 - crow(r, 0)]; p1[r] += tb[31 - crow(r, 0)]; }
                if (dil_fixed) exp_sum(p0, p1, l_part); else online_step(p0, p1, m_run, l_part, o);
                pv(o, p0, p1, lds + L_V + tt * 8192, lane);
            }
            const float l_run = other_half_sum(l_part);
            oscale = 1.f / l_run; lse = ((dil_fixed ? m_dil : m_run) + __builtin_amdgcn_logf(l_run)) * LN2;
        } else {
            const int v2 = u - AT_NFOX - AT_NDIL, qb = 15 - v2 / 48, bh = v2 % 48, b = bh / 6, h = bh % 6, q0 = qb * 256;
            const size_t rb = (size_t)b * S;
            const bf16_t* Kb = proj + ((size_t)(40 + h) * NTOK + rb) * 64;
            const bf16_t* Vb = proj + ((size_t)(46 + h) * NTOK + rb) * 64;
            const int tw = q0 + 32 * wid, t = tw + r32;
            const int jhi = (q0 + 254) >> 6, jhi_w = (tw + 30) >> 6, T = jhi + 1;
            float P_run = 1.f; bool wdone = false;
            int issued = 3; bool alldone = false;
            for (int i = 0; i < T; ++i) {
                if (i > 0) {
                    const int n = issued - 1 - i; AT_WAIT_BAR(2, n);
                    int c = 0;
#pragma unroll
                    for (int k = 0; k < 8; ++k) c += flags[((i - 1) & 1) * 8 + k];
                    alldone = (c == 8);
                }
                if (alldone) break;
                if (issued < T) { SB_ISSUE(issued); ++issued; }
                const int j = jhi - i, buf = i & 3;
                if (j <= jhi_w && !wdone) {
                    f32x16 p0, p1;
                    qkt(p0, p1, lds + L_K + buf * 8192, qr, 0.f, r32, hi);
                    const bool diag = (64 * j + 63 >= tw);
                    float gp[8];
#define SB_GROUPS(MASKED) _Pragma("unroll") for (int blk = 0; blk < 2; ++blk) _Pragma("unroll") for (int g = 0; g < 4; ++g) { float s4 = 1.f; \
                        _Pragma("unroll") for (int jj = 3; jj >= 0; --jj) { const int r = 4 * g + jj, s0 = 64 * j + 32 * blk + crow(r, hi); \
                            const float e = __builtin_amdgcn_exp2f(blk ? p1[r] : p0[r]); \
                            float keep = __builtin_amdgcn_rcpf(1.f + e), beta = 1.f - keep; \
                            if (MASKED) { if (s0 >= t) { keep = 1.f; beta = 0.f; } } \
                            if (blk) p1[r] = beta * s4; else p0[r] = beta * s4; \
                            s4 *= keep; } \
                        gp[4 * blk + g] = s4; }
                    if (diag) { asm volatile("; stick-breaking: diagonal tile (masked)" ::: "memory"); SB_GROUPS(true) } else { SB_GROUPS(false) }
#undef SB_GROUPS
                    float tail = 1.f;
#pragma unroll
                    for (int k = 7; k >= 0; --k) {
                        auto rr = __builtin_amdgcn_permlane32_swap(__float_as_uint(gp[k]), __float_as_uint(gp[k]), false, false);
                        const float lo = __uint_as_float(rr[0]), up = __uint_as_float(rr[1]);
                        const float mul = P_run * tail * (hi == 0 ? up : 1.f);
                        const int blk = k >> 2, g = k & 3;
#pragma unroll
                        for (int jj = 0; jj < 4; ++jj) { const int r = 4 * g + jj; if (blk) p1[r] *= mul; else p0[r] *= mul; }
                        tail *= lo * up;
                    }
                    P_run *= tail;
                    pv(o, p0, p1, lds + L_V + buf * 8192, lane);
                    wdone = __all(P_run < 1.1754944e-38f);
                }
                if (lane == 0) flags[(i & 1) * 8 + wid] = wdone ? 1 : 0;
            }
        }
        }
        if (tid == 0) info[1] = AT_QMAP((int)nextu);
        asm volatile("s_waitcnt vmcnt(0) lgkmcnt(0)\n\ts_barrier" ::: "memory");
        const int un = info[1];
        if (un < AT_NUNITS) prologue(un);
        if (on && !(dbg & 4)) {
            if (u < AT_NFOX) {
                const int qb = 15 - (u >> 5), bh = u & 31, b = bh >> 2, h = bh & 3, tw = qb * 256 + 32 * wid;
                const size_t rb = (size_t)b * S;
                const bf16_t* G = proj + ((size_t)(12 + h) * NTOK + rb + tw) * 64;
                bf16_t* O = mix + ((size_t)h * NTOK + rb + tw) * 64;
                store_o(o, oscale, lds, wid, lane, [&](int row) { return O + (size_t)row * 64; }, [&](int row) { return G + (size_t)row * 64; }, true);
            } else if (u < AT_NFOX + AT_NDIL) {
                const int v2 = u - AT_NFOX, bh = v2 % 48, rest = v2 / 48, b = bh / 6, h = bh % 6, p = rest >> 4, x = rest & 15;
                const int dil = p == 0 ? 1 : p == 1 ? 4 : 16, res = x % dil, nb2 = x / dil;
                const size_t rb = (size_t)b * S;
                const int mw = 256 * nb2 + 32 * wid;
                bf16_t* O = dilo + (((size_t)p * 6 + h) * NTOK + rb) * 64;
                const size_t mw_row = (size_t)mw * dil + res;
                store_o(o, oscale, lds, wid, lane, [&](int row) { return O + (mw_row + (size_t)row * dil) * 64; }, [&](int row) { return (const bf16_t*)nullptr; }, false);
                if (hi == 0) dill[((size_t)p * 6 + h) * NTOK + rb + (size_t)(mw + r32) * dil + res] = lse;
            } else {
                const int v2 = u - AT_NFOX - AT_NDIL, qb = 15 - v2 / 48, bh = v2 % 48, b = bh / 6, h = bh % 6, tw = qb * 256 + 32 * wid;
                const size_t rb = (size_t)b * S;
                bf16_t* O = mix + ((size_t)(10 + h) * NTOK + rb + tw) * 64;
                store_o(o, 1.f, lds, wid, lane, [&](int row) { return O + (size_t)row * 64; }, [&](int row) { return (const bf16_t*)nullptr; }, false);
            }
        }
        prev_st = on && !(dbg & 4);
        u = un;
    }
    asm volatile("s_waitcnt vmcnt(0) lgkmcnt(0)\n\ts_barrier" ::: "memory");
#undef AT_QMAP
#undef AT_WAIT_BAR
#undef FOX_ISSUE
#undef SB_ISSUE
#undef UNIT_ON
}

__device__ __forceinline__ void att_pv_packed(att::f32x16 (&o)[2], const u32x4 (&pw)[4], const LAS unsigned char* Vb, int lane) {
    using namespace att;
    const int hi = lane >> 5;
    unsigned va = (unsigned)(uintptr_t)Vb + ((lane >> 4) & 1) * 32 + (lane & 3) * 8 + (4 * hi + ((lane & 15) >> 2)) * 64; asm volatile("" : "+v"(va));
    const LAS unsigned char* vp = (const LAS unsigned char*)(uintptr_t)va;
    s16x4 vlo[8], vhh[8];
#pragma unroll
    for (int i = 0; i < 8; ++i) { vlo[i] = vtr(vp + (i >> 2) * 4096 + (i & 3) * 1024); vhh[i] = vtr(vp + (i >> 2) * 4096 + (i & 3) * 1024 + 512); }
    __builtin_amdgcn_sched_barrier(0);
#pragma unroll
    for (int d0 = 0; d0 < 2; ++d0)
#pragma unroll
        for (int ks = 0; ks < 4; ++ks) {
            const s16x4 lo = vlo[4 * d0 + ks], hh = vhh[4 * d0 + ks];
            const bf16x8 vf = (bf16x8){lo[0], lo[1], lo[2], lo[3], hh[0], hh[1], hh[2], hh[3]};
            o[d0] = __builtin_amdgcn_mfma_f32_32x32x16_bf16(vf, __builtin_bit_cast(bf16x8, pw[ks]), o[d0], 0, 0, 0);
        }
}

__device__ __forceinline__ void at_dil(const Args& a, LAS unsigned char* lds, int layer) {
    using namespace att;
    const int tid = opaque_tid(), wid = __builtin_amdgcn_readfirstlane(tid >> 6);
    const bf16_t* proj = (const bf16_t*)(a.ws + WS_PROJ);
    bf16_t* dilo = (bf16_t*)a.out;
    float* dill = (float*)(a.ws + WS_DILL);
    unsigned* queue = (unsigned*)(a.ws + WS_CTL) + CW_QUEUE + (layer + 4) * 64;
    LAS int* info = (LAS int*)(lds + L_INFO);
    LAS float* tab = (LAS float*)(lds + L_TAB);
    LAS float* relb = (LAS float*)(lds + SEG_OFF + 256);
    float bdil, bmax;
    { const int l64 = tid & 63;
      float g2 = fabsf(a.in[I_QGD][layer * 64 + l64]), g3 = fabsf(a.in[I_KGD][layer * 64 + l64]);
      float rbm = 0.f;
      for (int i = l64; i < 32 * 6; i += 64) rbm = fmaxf(rbm, a.in[I_RELB][i]);
#pragma unroll
      for (int o2 = 1; o2 < 64; o2 <<= 1) { g2 = fmaxf(g2, __shfl_xor(g2, o2)); g3 = fmaxf(g3, __shfl_xor(g3, o2)); rbm = fmaxf(rbm, __shfl_xor(rbm, o2)); }
      bdil = 8.f * g2 * g3 * LOG2E * 1.01f; bmax = fmaxf(rbm, 0.f) * LOG2E; }
    const bool dil_fixed = (bdil + bmax) < 40.f;
    const float m_dil = bdil + bmax;
    const unsigned l0 = (unsigned)(uintptr_t)lds;
    __syncthreads();
    if (tid < 32 * 6) relb[tid] = a.in[I_RELB][tid] * LOG2E;
    if (tid == 0) info[1] = (int)__hip_atomic_fetch_add(queue, 2u, __ATOMIC_RELAXED, __HIP_MEMORY_SCOPE_AGENT);
    __syncthreads();

    bf16x8 qr[4];
    auto issue_k = [&](int v) {
        int lane = tid & 63; asm volatile("" : "+v"(lane));
        const int r32 = lane & 31, hi = lane >> 5;
        const int bh = v % 48, rest = v / 48, b = bh / 6, h = bh % 6, p = rest >> 4, x = rest & 15;
        const int dil = p == 0 ? 1 : p == 1 ? 4 : 16, res = x % dil, nb2 = x / dil;
        const size_t rb = (size_t)b * S;
        const bf16_t* Kb = proj + ((size_t)(22 + h) * NTOK + rb) * 64;
        const int mk_base = 256 * nb2 - 128, tt_lo = nb2 == 0 ? 2 : 0;
        const size_t rs = (size_t)64 * dil;
        const int krow = 8 * wid + (lane >> 3), kch = (lane & 7) ^ ((krow >> 1) & 7);
#pragma unroll
        for (int tt = 5; tt >= 0; --tt) if (tt >= tt_lo)
            glds16(Kb + ((size_t)(mk_base + 64 * tt) * dil + res) * 64 + (size_t)krow * rs + kch * 8, (unsigned)__builtin_amdgcn_readfirstlane(l0 + L_K + tt * 8192 + wid * 1024));
        if (tid < 256) { const int st = tid - 64; tab[tid] = (st >= 0 && st <= 128) ? relb[t5_bucket(st * dil) * 6 + h] : -INFINITY; }
        const size_t trow = (size_t)(256 * nb2 + 32 * wid + r32) * dil + res;
        const bf16_t* Q = proj + ((size_t)(16 + h) * NTOK + rb + trow) * 64;
#pragma unroll
        for (int d0 = 0; d0 < 4; ++d0) qr[d0] = *(const bf16x8*)(Q + d0 * 16 + hi * 8);
    };
    auto issue_v = [&](int v) {
        int lane = tid & 63; asm volatile("" : "+v"(lane));
        const int bh = v % 48, rest = v / 48, b = bh / 6, h = bh % 6, p = rest >> 4, x = rest & 15;
        const int dil = p == 0 ? 1 : p == 1 ? 4 : 16, res = x % dil, nb2 = x / dil;
        const bf16_t* Vb = proj + ((size_t)(28 + h) * NTOK + (size_t)b * S) * 64;
        const int mk_base = 256 * nb2 - 128, tt_lo = nb2 == 0 ? 2 : 0;
        const size_t rs = (size_t)64 * dil;
#pragma unroll
        for (int tt = 5; tt >= 0; --tt) if (tt >= tt_lo)
            glds16(Vb + ((size_t)(mk_base + 64 * tt) * dil + res) * 64 + (size_t)(16 * (wid & 3) + (lane >> 2)) * rs + (wid >> 2) * 32 + (lane & 3) * 8, (unsigned)__builtin_amdgcn_readfirstlane(l0 + L_V + tt * 8192 + wid * 1024));
    };

    int u = info[1], un = u + 1;
    if (u < AT_NDIL) { issue_k(u); issue_v(u); }
    bool prev_st = false;
    while (u < AT_NDIL) {
        const int rest = u / 48, x = rest & 15, p = rest >> 4, bh = u % 48, b = bh / 6, h = bh % 6;
        const int dil = p == 0 ? 1 : p == 1 ? 4 : 16, res = x % dil, nb2 = x / dil;
        const int tt_lo = nb2 == 0 ? 2 : 0;
        if (tt_lo == 0) { if (prev_st) asm volatile("s_waitcnt vmcnt(11) lgkmcnt(0)\n\ts_barrier" ::: "memory"); else asm volatile("s_waitcnt vmcnt(6) lgkmcnt(0)\n\ts_barrier" ::: "memory"); }
        else { if (prev_st) asm volatile("s_waitcnt vmcnt(9) lgkmcnt(0)\n\ts_barrier" ::: "memory"); else asm volatile("s_waitcnt vmcnt(4) lgkmcnt(0)\n\ts_barrier" ::: "memory"); }
        int lane_ = tid & 63; asm volatile("" : "+v"(lane_));
        const int lane = lane_, r32 = lane & 31, hi = lane >> 5;
        asm volatile("" : "+v"(qr[0]), "+v"(qr[1]), "+v"(qr[2]), "+v"(qr[3]));
        unsigned nextu = 0;
        if (tid == 0) nextu = __hip_atomic_fetch_add(queue, 1u, __ATOMIC_RELAXED, __HIP_MEMORY_SCOPE_AGENT);
        const int twlo = wid >> 1;
        u32x4 pw[3][4];
        float l_part = 0.f, m_run = -INFINITY;
        if (dil_fixed) {
#pragma unroll
            for (int j = 0; j < 3; ++j) {
                const int tt = twlo + 2 - j;
                if (tt >= tt_lo) {
                    f32x16 p0, p1;
                    qkt(p0, p1, lds + L_K + tt * 8192, qr, -m_dil, r32, hi);
                    const LAS float* tb = tab + (32 * wid + r32 + 192 - 64 * tt - 4 * hi - 63);
#pragma unroll
                    for (int r = 0; r < 16; ++r) { p0[r] += tb[63 - crow(r, 0)]; p1[r] += tb[31 - crow(r, 0)]; }
                    exp_sum(p0, p1, l_part);
                    pw[j][0] = (u32x4){cvtpk(p0[0], p0[1]), cvtpk(p0[2], p0[3]), cvtpk(p0[4], p0[5]), cvtpk(p0[6], p0[7])};
                    pw[j][1] = (u32x4){cvtpk(p0[8], p0[9]), cvtpk(p0[10], p0[11]), cvtpk(p0[12], p0[13]), cvtpk(p0[14], p0[15])};
                    pw[j][2] = (u32x4){cvtpk(p1[0], p1[1]), cvtpk(p1[2], p1[3]), cvtpk(p1[4], p1[5]), cvtpk(p1[6], p1[7])};
                    pw[j][3] = (u32x4){cvtpk(p1[8], p1[9]), cvtpk(p1[10], p1[11]), cvtpk(p1[12], p1[13]), cvtpk(p1[14], p1[15])};
                }
            }
        } else {
            float mt = -INFINITY;
#pragma unroll 1
            for (int j = 0; j < 3; ++j) {
                const int tt = twlo + 2 - j;
                if (tt >= tt_lo) {
                    f32x16 p0, p1;
                    qkt(p0, p1, lds + L_K + tt * 8192, qr, 0.f, r32, hi);
                    const LAS float* tb = tab + (32 * wid + r32 + 192 - 64 * tt - 4 * hi - 63);
#pragma unroll
                    for (int r = 0; r < 16; ++r) mt = fmaxf(mt, fmaxf(p0[r] + tb[63 - crow(r, 0)], p1[r] + tb[31 - crow(r, 0)]));
                }
            }
            mt = other_half_max(mt);
            m_run = mt;
#pragma unroll
            for (int j = 0; j < 3; ++j) {
                const int tt = twlo + 2 - j;
                if (tt >= tt_lo) {
                    f32x16 p0, p1;
                    qkt(p0, p1, lds + L_K + tt * 8192, qr, -mt, r32, hi);
                    const LAS float* tb = tab + (32 * wid + r32 + 192 - 64 * tt - 4 * hi - 63);
#pragma unroll
                    for (int r = 0; r < 16; ++r) { p0[r] += tb[63 - crow(r, 0)]; p1[r] += tb[31 - crow(r, 0)]; }
                    exp_sum(p0, p1, l_part);
                    pw[j][0] = (u32x4){cvtpk(p0[0], p0[1]), cvtpk(p0[2], p0[3]), cvtpk(p0[4], p0[5]), cvtpk(p0[6], p0[7])};
                    pw[j][1] = (u32x4){cvtpk(p0[8], p0[9]), cvtpk(p0[10], p0[11]), cvtpk(p0[12], p0[13]), cvtpk(p0[14], p0[15])};
                    pw[j][2] = (u32x4){cvtpk(p1[0], p1[1]), cvtpk(p1[2], p1[3]), cvtpk(p1[4], p1[5]), cvtpk(p1[6], p1[7])};
                    pw[j][3] = (u32x4){cvtpk(p1[8], p1[9]), cvtpk(p1[10], p1[11]), cvtpk(p1[12], p1[13]), cvtpk(p1[14], p1[15])};
                }
            }
        }
        if (tid == 0) info[1] = (int)nextu;
        if (prev_st) asm volatile("s_waitcnt vmcnt(5) lgkmcnt(0)\n\ts_barrier" ::: "memory");
        else asm volatile("s_waitcnt vmcnt(0) lgkmcnt(0)\n\ts_barrier" ::: "memory");
        const int un2 = info[1];
        if (un < AT_NDIL) issue_k(un);
        f32x16 o[2]; o[0] = (f32x16){}; o[1] = (f32x16){};
#pragma unroll
        for (int j = 0; j < 3; ++j) {
            const int tt = twlo + 2 - j;
            if (tt >= tt_lo) att_pv_packed(o, pw[j], lds + L_V + tt * 8192, lane);
        }
        const float l_run = other_half_sum(l_part);
        const float oscale = 1.f / l_run, lse = ((dil_fixed ? m_dil : m_run) + __builtin_amdgcn_logf(l_run)) * LN2;
        asm volatile("s_waitcnt lgkmcnt(0)\n\ts_barrier" ::: "memory");
        if (un < AT_NDIL) issue_v(un);
        {
            const size_t rb = (size_t)b * S;
            const int mw = 256 * nb2 + 32 * wid;
            bf16_t* O = dilo + (((size_t)p * 6 + h) * NTOK + rb) * 64;
            const size_t mw_row = (size_t)mw * dil + res;
            store_o(o, oscale, lds, wid, lane, [&](int row) { return O + (mw_row + (size_t)row * dil) * 64; }, [&](int row) { return (const bf16_t*)nullptr; }, false);
            if (hi == 0) dill[((size_t)p * 6 + h) * NTOK + rb + (size_t)(mw + r32) * dil + res] = lse;
        }
        prev_st = true;
        u = un; un = un2;
    }
    asm volatile("s_waitcnt vmcnt(0) lgkmcnt(0)\n\ts_barrier" ::: "memory");
}

__device__ __forceinline__ void mg_merge(const Args& a) {
    const bf16_t* dilo = (const bf16_t*)a.out;
    const float* dill = (const float*)(a.ws + WS_DILL);
    bf16_t* mix = (bf16_t*)(a.ws + WS_ACT);
    const int tid = opaque_tid();
    const size_t total = (size_t)6 * NTOK * 8;
    for (size_t i = (size_t)blockIdx.x * NTHR + tid; i < total; i += (size_t)gridDim.x * NTHR) {
        const size_t ht = i >> 3; const int c = (int)(i & 7);
        const float l0 = dill[(size_t)0 * 6 * NTOK + ht], l1 = dill[(size_t)1 * 6 * NTOK + ht], l2 = dill[(size_t)2 * 6 * NTOK + ht];
        const float mx = fmaxf(l0, fmaxf(l1, l2));
        float w0 = __expf(l0 - mx), w1 = __expf(l1 - mx), w2 = __expf(l2 - mx);
        const float inv = 1.f / (w0 + w1 + w2); w0 *= inv; w1 *= inv; w2 *= inv;
        const u32x4 a0 = __builtin_nontemporal_load((const u32x4*)(dilo + ((size_t)0 * 6 * NTOK + ht) * 64 + c * 8));
        const u32x4 a1 = __builtin_nontemporal_load((const u32x4*)(dilo + ((size_t)1 * 6 * NTOK + ht) * 64 + c * 8));
        const u32x4 a2 = __builtin_nontemporal_load((const u32x4*)(dilo + ((size_t)2 * 6 * NTOK + ht) * 64 + c * 8));
        u32x4 r;
#pragma unroll
        for (int k = 0; k < 4; ++k) {
            const float x0 = w0 * __uint_as_float(a0[k] << 16) + w1 * __uint_as_float(a1[k] << 16) + w2 * __uint_as_float(a2[k] << 16);
            const float x1 = w0 * __uint_as_float(a0[k] & 0xffff0000u) + w1 * __uint_as_float(a1[k] & 0xffff0000u) + w2 * __uint_as_float(a2[k] & 0xffff0000u);
            r[k] = pk2(x0, x1);
        }
        *(u32x4*)(mix + ((size_t)4 * NTOK + ht) * 64 + c * 8) = r;
    }
}

__device__ __forceinline__ void cumsum_unit(const Args& a, LAS unsigned char* lds, int bh) {
    const int tid = opaque_tid(), b = bh >> 2, h = bh & 3;
    const float* flog = (const float*)(a.ws + WS_FLOG);
    float* cum = (float*)(a.ws + WS_CUM) + (size_t)bh * S;
    LAS double* sd = (LAS double*)lds;
    double loc[8]; double run = 0.0;
#pragma unroll
    for (int j = 0; j < 8; ++j) { run += (double)flog[((size_t)b * S + tid * 8 + j) * 4 + h]; loc[j] = run; }
    __syncthreads();
    sd[tid] = run;
    __syncthreads();
    if (tid == 0) { double s2 = 0.0; for (int i = 0; i < NTHR; ++i) { const double t = sd[i]; sd[i] = s2; s2 += t; } }
    __syncthreads();
    const double base = sd[tid];
#pragma unroll
    for (int j = 0; j < 8; ++j) cum[tid * 8 + j] = (float)(base + loc[j]);
    __syncthreads();
}
__device__ __forceinline__ void pj_mfma(const Args& a, LAS unsigned char* lds, int layer) {
    pg8::DenseOrder So; So.init(a.ws + WS_ACT, a.ws + WS_WIN + (size_t)layer * 3328 * D * 2, NTOK, 3328, D, gridDim.x, blockIdx.x);
    LAS float* gl = (LAS float*)(lds + SEG_OFF + 256);
    { const int t_ = opaque_tid(); if (t_ < 256) { const int w = t_ >> 6, i = t_ & 63; const float* gp_ = w == 0 ? a.in[I_QGF] : w == 1 ? a.in[I_KGF] : w == 2 ? a.in[I_QGD] : a.in[I_KGD]; gl[t_] = gp_[layer * 64 + i]; } }
    __syncthreads();
    EpiProj E{(bf16_t*)(a.ws + WS_PROJ), gl};
    pg8::gemm_phase<EpiProj, pg8::DenseOrder>(lds, D, So, E);
    if ((int)blockIdx.x >= (int)gridDim.x - 32) cumsum_unit(a, lds, blockIdx.x - (gridDim.x - 32));
    if (layer + 1 < NL) { __syncthreads(); p0_prep(a, lds, layer + 1, gridDim.x / 2, gridDim.x - gridDim.x / 2); }
}
__device__ __forceinline__ void op_mfma(const Args& a, LAS unsigned char* lds, int layer, bf16_t* outp = nullptr) {
    pg8::DenseOrder So; So.init(a.ws + WS_ACT, a.ws + WS_WOUT + (size_t)layer * D * D * 2, NTOK, D, D, gridDim.x, blockIdx.x, (size_t)256 * 128);
    bf16_t* xb = (bf16_t*)(a.ws + WS_XB);
    EpiOut E{layer == 0 ? a.in[I_X] : nullptr, xb, outp ? outp : xb, (const float*)(a.ws + WS_MOD) + (size_t)layer * NB * 6144 + 2048};
    pg8::gemm_phase<EpiOut, pg8::DenseOrder>(lds, D, So, E, 128u, (size_t)NTOK * 128);
}
__device__ __forceinline__ void seg_to_lds(const Args& a, LAS unsigned char* lds, int layer) {
    LAS int* seg = (LAS int*)(lds + SEG_OFF);
    if (threadIdx.x == 0) {
        unsigned* cnt = (unsigned*)(a.ws + WS_CTL) + CW_CNT + layer * 16 * 64;
        int o = 0;
        for (int e = 0; e < 16; ++e) { const int c = (int)__hip_atomic_load(cnt + e * 64, __ATOMIC_RELAXED, __HIP_MEMORY_SCOPE_AGENT); seg[e] = c; seg[16 + e] = o; o += (c + 255) & ~255; }
        seg[32] = o;
    }
    __syncthreads();
}
__device__ __forceinline__ void gu_mfma(const Args& a, LAS unsigned char* lds, int layer) {
    seg_to_lds(a, lds, layer);
    const LAS int* seg = (const LAS int*)(lds + SEG_OFF);
    pg8::GroupedOrder So{(const char*)(a.ws + WS_HS), (const char*)(a.ws + WS_WGU + (size_t)layer * NE * 1024 * D * 2), seg, 4, (int)gridDim.x, (int)blockIdx.x, (size_t)D * 2, (size_t)1024 * D * 2, (size_t)256 * D * 2};
    EpiGU E{(bf16_t*)(a.ws + WS_HID), seg};
    pg8::gemm_phase_gather<EpiGU, pg8::GroupedOrder>(lds, D, So, E, (const char*)(a.ws + WS_ACT), (const int*)(a.ws + WS_LIST), seg);
}
__device__ __forceinline__ void dn_mfma(const Args& a, LAS unsigned char* lds, int layer) {
    seg_to_lds(a, lds, layer);
    const LAS int* seg = (const LAS int*)(lds + SEG_OFF);
    pg8::GroupedOrder So{(const char*)(a.ws + WS_HID), (const char*)(a.ws + WS_WDN + (size_t)layer * NE * 1024 * DFF * 2), seg, 4, (int)gridDim.x, (int)blockIdx.x, (size_t)DFF * 2, (size_t)1024 * DFF * 2, (size_t)256 * DFF * 2};
    EpiDown E{(bf16_t*)(a.ws + WS_YBUF), (const int*)(a.ws + WS_LIST), (const float*)(a.ws + WS_LISTW), seg, lds};
    pg8::gemm_phase<EpiDown, pg8::GroupedOrder>(lds, DFF, So, E);
}

#ifndef MF_PJ
#define MF_PJ 1
#endif
#ifndef MF_OP
#define MF_OP 1
#endif
#ifndef MF_GU
#define MF_GU 1
#endif
#ifndef MF_AT
#define MF_AT 1
#endif
#ifndef MF_DN
#define MF_DN 1
#endif
__global__ void __launch_bounds__(NTHR, 2) mega_fwd(Args a) {
    extern __shared__ __attribute__((aligned(16))) unsigned char lds_raw[];
    LAS unsigned char* lds = (LAS unsigned char*)lds_raw;
    volatile LAS unsigned* MISC = (volatile LAS unsigned*)(lds + MISC_OFF);
    if (threadIdx.x < 32) MISC[threadIdx.x] = 0u;
    __syncthreads();
    XcdBarrier bar = xcd_barrier_post((unsigned*)(a.ws + WS_CTL) + CW_BAR, MISC + 8);

    p0_mod(a, lds);
    p0_prep(a, lds, 0, 0, gridDim.x);
    xcd_barrier(bar);
#pragma unroll 1
    for (int layer = 0; layer < NL; ++layer) {
        n1_norm(a, lds, layer);
        xcd_barrier(bar);
        pj_mfma(a, lds, layer);
        xcd_barrier(bar);
#pragma unroll 1
        for (int ph = 0; ph < 2; ++ph) {
            if (((ph ^ (int)blockIdx.x) & 1) == 0) at_mfma(a, lds, layer);
            else at_dil(a, lds, layer);
        }
        xcd_barrier(bar);
        mg_merge(a);
        xcd_barrier(bar);
        op_mfma(a, lds, layer);
        xcd_barrier(bar);
        n2_mfma(a, lds, layer);
        xcd_barrier(bar);
        gu_mfma(a, lds, layer);
        xcd_barrier(bar);
        dn_mfma(a, lds, layer);
        xcd_barrier(bar);
    }
    fin_combine(a, NL - 1);
}

extern "C" void kernel_launch(void* const* d_in, const int* in_sizes, int n_in, void* d_out, int out_size, void* d_ws, size_t ws_size, hipStream_t stream) {
    static int grid = 0;
    if (grid == 0) {
        if (n_in != 19 || out_size != NTOK * D || ws_size < WS_END) { fprintf(stderr, "kernel_launch: unexpected shapes (n_in %d out %d ws %zu)\n", n_in, out_size, ws_size); grid = -1; return; }
        int dev = 0, cus = 0;
        if (hipGetDevice(&dev) != hipSuccess || hipDeviceGetAttribute(&cus, hipDeviceAttributeMultiprocessorCount, dev) != hipSuccess) { grid = -1; return; }
        if (hipFuncSetAttribute((const void*)mega_fwd, hipFuncAttributeMaxDynamicSharedMemorySize, LDS_BYTES) != hipSuccess) { fprintf(stderr, "kernel_launch: hipFuncSetAttribute failed\n"); grid = -1; return; }
        int per_cu = 0;
        if (hipOccupancyMaxActiveBlocksPerMultiprocessor(&per_cu, (const void*)mega_fwd, NTHR, LDS_BYTES) != hipSuccess || per_cu < 1) { fprintf(stderr, "kernel_launch: occupancy query says %d\n", per_cu); }
        (void)hipGetLastError();
        grid = cus;
    }
    if (grid < 0) return;
    if (hipMemsetAsync((char*)d_ws + WS_CTL, 0, CTL_ZERO_BYTES, stream) != hipSuccess) return;
    Args a{};
    for (int i = 0; i < 19; ++i) a.in[i] = (const float*)d_in[i];
    a.out = (float*)d_out; a.ws = (unsigned char*)d_ws;
    hipLaunchKernelGGL(mega_fwd, dim3(grid), dim3(NTHR), LDS_BYTES, stream, a);
}
```

```cpp
#include <hip/hip_runtime.h>
#include <cstdio>
#include <cstdint>

#define GAS __attribute__((address_space(1)))
#define LAS __attribute__((address_space(3)))
typedef unsigned short bf16_t;
typedef float f32x4 __attribute__((ext_vector_type(4)));
typedef unsigned u32x4 __attribute__((ext_vector_type(4)));
typedef unsigned u32x2 __attribute__((ext_vector_type(2)));

constexpr int NB = 8, S = 4096, D = 1024, NTOK = NB * S, NL = 2;
constexpr int HD = 64, NSLOT = 52, IN_COLS = 3332;
constexpr int NE = 16, DFF = 512;
constexpr int NWAVES = 8, NTHR = 512;
constexpr float RMS_EPS = 1e-6f;
constexpr float LOG2E = 1.4426950408889634f;
constexpr float LN2 = 0.6931471805599453f;

enum SlotType { ST_QFOX = 0, ST_KFOX, ST_V, ST_G, ST_QDIL, ST_KDIL, ST_QSB, ST_K };
__host__ __device__ constexpr int slot_col(int s) {
    return s < 16 ? 64 * s : 1028 + 64 * (s - 16);
}
__host__ __device__ constexpr int slot_type(int s) {
    return s < 4 ? ST_QFOX : s < 8 ? ST_KFOX : s < 12 ? ST_V : s < 16 ? ST_G : s < 22 ? ST_QDIL : s < 28 ? ST_KDIL : s < 34 ? ST_V : s < 40 ? ST_QSB : s < 46 ? ST_K : ST_V;
}

constexpr size_t MiB = 1u << 20;
constexpr size_t WS_CTL = 0, CTL_ZERO_BYTES = 1 * MiB;
constexpr size_t WS_MOD = 1 * MiB;
constexpr size_t WS_FLOG = WS_MOD + 512 * 1024;
constexpr size_t WS_CUM = 2 * MiB;
constexpr size_t WS_LIST = 3 * MiB;
constexpr size_t WS_LISTW = 5 * MiB;
constexpr size_t WS_DILL = 7 * MiB;
constexpr size_t WS_WIN = 10 * MiB;
constexpr size_t WS_WOUT = 23 * MiB;
constexpr size_t WS_WGU = 27 * MiB;
constexpr size_t WS_WDN = 91 * MiB;
constexpr size_t WS_ACT = 124 * MiB;
constexpr size_t WS_PROJ = 188 * MiB;
constexpr size_t WS_HS = 188 * MiB;
constexpr size_t WS_HID = 324 * MiB;
constexpr size_t WS_YBUF = 188 * MiB;
constexpr size_t WS_XB = 396 * MiB;
constexpr size_t WS_END = 468 * MiB;
constexpr int CW_BAR = 4096;
constexpr int CW_CNT = 16384;
constexpr int LDS_BYTES = 147456;
constexpr int MISC_OFF = 138240;
constexpr int SEG_OFF = 138752;

#ifndef MF_FOX
#define MF_FOX 1
#endif
#ifndef MF_DIL
#define MF_DIL 1
#endif
#ifndef MF_SB
#define MF_SB 1
#endif
__device__ __forceinline__ float bf2f(bf16_t v) { return __uint_as_float(((unsigned)v) << 16); }
__device__ __forceinline__ unsigned f2bf(float f) { unsigned u = __float_as_uint(f); return (u + 0x7fffu + ((u >> 16) & 1u)) >> 16; }
typedef float pk2_f32x2 __attribute__((ext_vector_type(2))); typedef __bf16 pk2_bf16x2 __attribute__((ext_vector_type(2)));
__device__ __forceinline__ unsigned pk2(float lo, float hi) { pk2_f32x2 v = {lo, hi}; pk2_bf16x2 b = __builtin_convertvector(v, pk2_bf16x2); return __builtin_bit_cast(unsigned, b); }
__device__ __forceinline__ float wave_sum(float v) {
#pragma unroll
    for (int o = 1; o < 64; o <<= 1) v += __shfl_xor(v, o);
    return v;
}
__device__ __forceinline__ float log_sigmoid_f(float v) { return fminf(v, 0.f) - log1pf(expf(-fabsf(v))); }

#define XB_TMO      128
#define XB_XCNT(j)  (256  + 64 * (j))
#define XB_XSUB(j)  (1280 + 64 * (j))
#define XB_XGEN(j)  (2304 + 64 * (j))
#define XB_TOP      3328
#define XB_TOPGEN   3392
#define XCD_BAR_WORDS 3456
#define XB_SPIN_CAP (1u << 24)
__device__ __forceinline__ unsigned xb_ld(unsigned* p)              { return __hip_atomic_load(p, __ATOMIC_RELAXED, __HIP_MEMORY_SCOPE_AGENT); }
__device__ __forceinline__ unsigned xb_add(unsigned* p, unsigned v) { return __hip_atomic_fetch_add(p, v, __ATOMIC_RELAXED, __HIP_MEMORY_SCOPE_AGENT); }
__device__ __forceinline__ unsigned xb_xcc_id() { return (unsigned)__builtin_amdgcn_s_getreg((3 << 11) | 20) & 0xFu; }
#define XB_SPIN(cond, bar) do { unsigned _sp = 0; while (cond) { __builtin_amdgcn_s_sleep(1); \
    if ((++_sp & 255u) == 0u) { if (xb_ld(&(bar)[XB_TMO])) break; if (_sp > XB_SPIN_CAP) { atomicAdd(&(bar)[XB_TMO], 1u); break; } } } } while (0)
struct XcdBarrier { unsigned* bar; unsigned x; volatile LAS unsigned* st; };
__device__ __forceinline__ XcdBarrier xcd_barrier_post(unsigned* bar, volatile LAS unsigned* st) {
    XcdBarrier b; b.bar = bar; b.x = xb_xcc_id(); b.st = st;
    if (threadIdx.x == 0) (void)xb_add(&bar[XB_XCNT(b.x)], 1u);
    return b;
}
__device__ __forceinline__ void xcd_barrier_complete(unsigned* bar, unsigned x, unsigned& nloc, unsigned& nx) {
    const unsigned G = gridDim.x * gridDim.y * gridDim.z;
    unsigned sum, cnt, mine, sp = 0u;
    for (;;) {
        sum = 0u; cnt = 0u; mine = 0u;
#pragma unroll
        for (unsigned j = 0; j < 16; ++j) { const unsigned c = xb_ld(&bar[XB_XCNT(j)]); sum += c; cnt += (c > 0u) ? 1u : 0u; mine = (j == x) ? c : mine; }
        if (sum == G) break;
        __builtin_amdgcn_s_sleep(1);
        if ((++sp & 255u) == 0u) { if (xb_ld(&bar[XB_TMO])) break; if (sp > XB_SPIN_CAP) { atomicAdd(&bar[XB_TMO], 1u); break; } }
    }
    nloc = mine > 0u ? mine : 1u; nx = cnt > 0u ? cnt : 1u;
}
__device__ __forceinline__ void xcd_barrier(const XcdBarrier& b) {
    asm volatile("s_waitcnt vmcnt(0)" ::: "memory");
    __syncthreads();
    if (threadIdx.x == 0) {
        unsigned* bar = b.bar; unsigned bx = b.x;
        asm volatile("" : "+s"(bar), "+s"(bx));
        __builtin_amdgcn_s_waitcnt(0);
        unsigned nloc = b.st[0], nx = b.st[1];
        if (nloc == 0u) { xcd_barrier_complete(bar, bx, nloc, nx); b.st[0] = nloc; b.st[1] = nx; }
        const unsigned old = xb_add(&bar[XB_XSUB(bx)], 1u);
        const unsigned gen = old / nloc;
        if (old + 1u == (gen + 1u) * nloc) {
            __builtin_amdgcn_fence(__ATOMIC_RELEASE, "agent");
            asm volatile("s_waitcnt vmcnt(0)" ::: "memory");
            const unsigned og = xb_add(&bar[XB_TOP], 1u);
            const unsigned tg = og / nx;
            if (og + 1u == (tg + 1u) * nx) xb_add(&bar[XB_TOPGEN], 1u);
            else XB_SPIN(xb_ld(&bar[XB_TOPGEN]) == tg, bar);
            __builtin_amdgcn_fence(__ATOMIC_ACQUIRE, "agent");
            xb_add(&bar[XB_XGEN(bx)], 1u);
            asm volatile("s_waitcnt vmcnt(0)" ::: "memory");
        } else {
            XB_SPIN(xb_ld(&bar[XB_XGEN(bx)]) == gen, bar);
            __builtin_amdgcn_fence(__ATOMIC_ACQUIRE, "agent");
            asm volatile("s_waitcnt vmcnt(0)" ::: "memory");
        }
    }
    __syncthreads();
}

struct Args { const float* in[19]; float* out; unsigned char* ws; };
enum InIdx { I_X = 0, I_C, I_ADAW, I_ADAB, I_NMIX, I_NFFN, I_WIN, I_BFORGET, I_QGF, I_KGF, I_QGD, I_KGD, I_RELB, I_WOUT, I_RW, I_RB, I_WG, I_WU, I_WD };

__device__ __forceinline__ int opaque_tid() { int t = threadIdx.x; asm volatile("" : "+v"(t)); return t; }

__device__ __forceinline__ void lds_dma4(const void* gsrc, unsigned lds_dst) { unsigned keep;
    asm volatile("s_mov_b32 %0, m0\n\ts_mov_b32 m0, %2\n\ts_nop 0\n\tglobal_load_lds_dword %1, off\n\ts_mov_b32 m0, %0" : "=&s"(keep) : "v"(gsrc), "s"(lds_dst) : "memory"); }
constexpr int DNSL_OFF = 140288;
namespace pg8 {
typedef short bf16x8 __attribute__((ext_vector_type(8)));
constexpr int BM = 256, BK = 64, HALF = 128, HTB = HALF * BK * 2, STAGE_BYTES = 8 * HTB, NXCD = 8, WGM = 8;
__host__ __device__ __forceinline__ int lds_byte(int r, int c) { const int st = (r >> 4) * 2 + (c >> 5), rr = r & 15, cc = c & 31, ob = rr * 64 + cc * 2; return st * 1024 + (ob ^ (((ob >> 9) & 1) << 5)); }
__host__ __device__ __forceinline__ void stage_rc(int b, int& R, int& C) { const int st = b / 1024, sb = b % 1024, swz = sb ^ (((sb >> 9) & 1) << 5); R = (st >> 1) * 16 + swz / 64; C = (st & 1) * 32 + (swz % 64) / 2; }
__host__ __device__ __forceinline__ int perm32(int rho) { const int n = rho >> 4, i = rho & 15; return 8 * (i >> 2) + 4 * n + (i & 3); }
struct Unit { const char* a; const char* b; int pm, pn, e, rows, par; };
__device__ __forceinline__ unsigned cvt_pk_bf16(float lo, float hi) { unsigned r; asm volatile("v_cvt_pk_bf16_f32 %0, %1, %2" : "=v"(r) : "v"(lo), "v"(hi)); return r; }

struct DenseOrder {
    const char* A; const char* Bt; int nM, nN, nwg, G, c; size_t tstep, tstepA;
    __device__ void init(const void* A_, const void* Bt_, int M, int N, int K, int G_, int c_, size_t tstepA_ = 0) { A = (const char*)A_; Bt = (const char*)Bt_; nM = M / BM; nN = N / BM; nwg = nM * nN; G = G_; c = c_; tstep = (size_t)BM * K * 2; tstepA = tstepA_ ? tstepA_ : tstep; }
    __device__ __forceinline__ bool next(int i, Unit& u) const {
        const long L = (long)i * G + c; if (L >= nwg) return false;
        int wgid = (int)L; { const int q = nwg / NXCD, r = nwg % NXCD, xcd = wgid % NXCD, off = wgid / NXCD; wgid = (xcd < r ? xcd * (q + 1) : r * (q + 1) + (xcd - r) * q) + off; }
        const int nig = WGM * nN, gid = wgid / nig, fm = gid * WGM, gsz = (nM - fm) < WGM ? (nM - fm) : WGM;
        u.pm = fm + ((wgid % nig) % gsz); u.pn = (wgid % nig) / gsz; u.e = 0; u.rows = 256;
        u.a = A + (size_t)u.pm * tstepA; u.b = Bt + (size_t)u.pn * tstep; return true;
    }
};
struct GroupedOrder {
    const char* A; const char* Bt; const LAS int* seg; int nct, G, c; size_t arow_bytes, bexp_bytes, btile_bytes;
    __device__ __forceinline__ bool next(int i, Unit& u) const {
        int U = i * G + c, e = 0, found = 0, rem = 0;
        typedef int i32x4 __attribute__((ext_vector_type(4)));
        const i32x4 c0 = *(const LAS i32x4*)(seg), c1 = *(const LAS i32x4*)(seg + 4), c2 = *(const LAS i32x4*)(seg + 8), c3 = *(const LAS i32x4*)(seg + 12);
#pragma unroll
        for (int k = 0; k < 16; ++k) { const int ck = k < 4 ? c0[k & 3] : k < 8 ? c1[k & 3] : k < 12 ? c2[k & 3] : c3[k & 3];
            const int nu = ((ck + 255) >> 8) * nct; if (!found) { if (U < nu) { found = 1; e = k; rem = U; } else U -= nu; } }
        if (!found) return false;
        e = __builtin_amdgcn_readfirstlane(e); rem = __builtin_amdgcn_readfirstlane(rem);
        const int rt = rem / nct, ct = rem % nct;
        u.e = e; u.pm = rt; u.pn = ct; u.rows = seg[e] - rt * 256;
        u.a = A + (size_t)(seg[16 + e] + rt * 256) * arow_bytes; u.b = Bt + (size_t)e * bexp_bytes + (size_t)ct * btile_bytes; return true;
    }
};

template <class Epi, class Sched>
__device__ __forceinline__ void gemm_phase(LAS unsigned char* lds, const int K, const Sched& S, const Epi& E, const unsigned lda_in = 0, const size_t kstepA_in = 0) {
    const int tid = opaque_tid(), wid = __builtin_amdgcn_readfirstlane(tid >> 6), lane = tid & 63, wr = wid >> 2, wc = wid & 3, fr = lane & 15, fq = lane >> 4;
    const int nt = K / BK;
    const unsigned ldaA = lda_in ? lda_in : (unsigned)(K * 2);
    unsigned voffA[2], voffB[2];
#pragma unroll
    for (int i = 0; i < 2; ++i) { int R, C; stage_rc(tid * 16 + i * 8192, R, C); const int Rb = Epi::PERM ? ((R & ~31) + perm32(R & 31)) : R;
        voffA[i] = (unsigned)R * ldaA + (unsigned)C * 2u; voffB[i] = (unsigned)(Rb * K + C) * 2u; }
    const size_t kstep = (size_t)(BK * 2);
    const size_t hstep = (size_t)HALF * K * 2;
    const size_t kstepA = kstepA_in ? kstepA_in : kstep, hstepA = (size_t)HALF * ldaA;
    const unsigned ldsw = (unsigned)wid * 1024u;
    const int aoff = lds_byte(wr * 64 + fr, fq * 8), boff = lds_byte(wc * 32 + fr, fq * 8);
#define PG8_SA(b, h) (((b) * 2 + (h)) * HTB)
#define PG8_SB(b, h) ((4 + (b) * 2 + (h)) * HTB)
#define PG8_STAGE(bufoff, gbase, voff) do { _Pragma("unroll") for (int _i = 0; _i < 2; ++_i) \
        __builtin_amdgcn_global_load_lds((const unsigned*)((const char*)(gbase) + (voff)[_i]), (LAS unsigned*)(lds + (bufoff) + ldsw + _i * 8192), 16, 0, 0); } while (0)
#define PG8_LDA(dst, b, h) do { _Pragma("unroll") for (int m = 0; m < 4; ++m) _Pragma("unroll") for (int k = 0; k < 2; ++k) dst[m][k] = *(const LAS bf16x8*)(lds + PG8_SA(b, h) + aoff + m * 2048 + k * 1024); } while (0)
#define PG8_LDB(dst, b, h) do { _Pragma("unroll") for (int n = 0; n < 2; ++n) _Pragma("unroll") for (int k = 0; k < 2; ++k) dst[n][k] = *(const LAS bf16x8*)(lds + PG8_SB(b, h) + boff + n * 2048 + k * 1024); } while (0)
#define PG8_MMA(ai, bj, At, Bt) do { __builtin_amdgcn_s_setprio(1); _Pragma("unroll") for (int m = 0; m < 4; ++m) _Pragma("unroll") for (int n = 0; n < 2; ++n) _Pragma("unroll") for (int k = 0; k < 2; ++k) \
        acc[ai][bj][m][n] = __builtin_amdgcn_mfma_f32_16x16x32_bf16(Bt[n][k], At[m][k], acc[ai][bj][m][n], 0, 0, 0); __builtin_amdgcn_s_setprio(0); } while (0)
#define PG8_WAIT_V(n) asm volatile("s_waitcnt vmcnt(" #n ")" ::: "memory")
#define PG8_WAIT_L(n) asm volatile("s_waitcnt lgkmcnt(" #n ")" ::: "memory")
#define PG8_BAR __builtin_amdgcn_s_barrier()
#define PG8_SCHED __builtin_amdgcn_sched_barrier(0)
    Unit cur, nxt; int ui = 0;
    if (!S.next(0, cur)) return;
    f32x4 acc[2][2][4][2];
#pragma unroll
    for (int a = 0; a < 2; ++a)
#pragma unroll
        for (int b = 0; b < 2; ++b)
#pragma unroll
            for (int m = 0; m < 4; ++m)
#pragma unroll
                for (int n = 0; n < 2; ++n) acc[a][b][m][n] = (f32x4){0.f, 0.f, 0.f, 0.f};
    bf16x8 At[4][2], B0[2][2], B1[2][2];
    const char* cA = cur.a; const char* cB = cur.b;
    PG8_STAGE(PG8_SB(0, 0), cB, voffB); PG8_STAGE(PG8_SB(0, 1), cB + hstep, voffB); PG8_STAGE(PG8_SA(0, 0), cA, voffA); PG8_STAGE(PG8_SA(0, 1), cA + hstepA, voffA);
    if (wr == 1) PG8_BAR;
    PG8_WAIT_V(2); PG8_BAR;
    PG8_STAGE(PG8_SB(1, 0), cB + kstep, voffB); PG8_STAGE(PG8_SA(1, 0), cA + kstepA, voffA); PG8_STAGE(PG8_SB(1, 1), cB + hstep + kstep, voffB);
    PG8_WAIT_V(6); PG8_BAR;
    for (;;) {
        const bool hi_on = cur.rows > 128;
        cur.par = ui & 1; E.pre(lds, cur, tid);
        const bool has_next = S.next(ui + 1, nxt);
        const char* nA = has_next ? nxt.a : cA; const char* nB = has_next ? nxt.b : cB;
        for (int t = 0; t < nt; t += 2) {
            const bool last = (t == nt - 2);
            const char* a1 = cA + (size_t)(t + 1) * kstepA;
            const char* a2 = last ? nA : cA + (size_t)(t + 2) * kstepA; const char* b2 = last ? nB : cB + (size_t)(t + 2) * kstep;
            const char* a3 = a2 + kstepA; const char* b3 = b2 + kstep;
            PG8_LDB(B0, 0, 0); PG8_LDB(B1, 0, 1); PG8_SCHED; PG8_LDA(At, 0, 0); PG8_STAGE(PG8_SA(1, 1), a1 + hstepA, voffA);
            PG8_WAIT_V(8); PG8_WAIT_L(0); PG8_BAR; PG8_MMA(0, 0, At, B0); PG8_MMA(0, 1, At, B1); PG8_BAR; PG8_SCHED;
            PG8_LDA(At, 0, 1); PG8_STAGE(PG8_SB(0, 0), b2, voffB); PG8_STAGE(PG8_SB(0, 1), b2 + hstep, voffB); PG8_STAGE(PG8_SA(0, 0), a2, voffA);
            PG8_WAIT_V(8); PG8_WAIT_L(0); PG8_BAR; if (hi_on) { PG8_MMA(1, 0, At, B0); PG8_MMA(1, 1, At, B1); } PG8_BAR; PG8_SCHED;
            PG8_LDB(B0, 1, 0); PG8_LDB(B1, 1, 1); PG8_SCHED; PG8_LDA(At, 1, 0); PG8_STAGE(PG8_SA(0, 1), a2 + hstepA, voffA);
            PG8_WAIT_V(8); PG8_WAIT_L(0); PG8_BAR; PG8_MMA(0, 0, At, B0); PG8_MMA(0, 1, At, B1); PG8_BAR; PG8_SCHED;
            PG8_LDA(At, 1, 1); PG8_STAGE(PG8_SB(1, 0), b3, voffB); PG8_STAGE(PG8_SB(1, 1), b3 + hstep, voffB); PG8_STAGE(PG8_SA(1, 0), a3, voffA);
            PG8_WAIT_V(8); PG8_WAIT_L(0); PG8_BAR; if (hi_on) { PG8_MMA(1, 0, At, B0); PG8_MMA(1, 1, At, B1); } PG8_BAR; PG8_SCHED;
        }
        if (wr == 0) PG8_BAR;
        E(acc, cur, wr, wc, fr, fq);
        if (!has_next) break;
#pragma unroll
        for (int a = 0; a < 2; ++a)
#pragma unroll
            for (int b = 0; b < 2; ++b)
#pragma unroll
                for (int m = 0; m < 4; ++m)
#pragma unroll
                    for (int n = 0; n < 2; ++n) acc[a][b][m][n] = (f32x4){0.f, 0.f, 0.f, 0.f};
        cur = nxt; cA = nA; cB = nB; ++ui;
        if (wr == 1) PG8_BAR;
    }
    PG8_WAIT_V(0);
    PG8_BAR;
#undef PG8_SA
#undef PG8_SB
#undef PG8_STAGE
#undef PG8_LDA
#undef PG8_LDB
#undef PG8_MMA
#undef PG8_WAIT_V
#undef PG8_WAIT_L
#undef PG8_BAR
#undef PG8_SCHED
}
template <class Epi, class Sched>
__device__ __forceinline__ void gemm_phase_gather(LAS unsigned char* lds, const int K, const Sched& S, const Epi& E, const char* Ag, const int* list, const LAS int* seg) {
    const int tid = opaque_tid(), wid = __builtin_amdgcn_readfirstlane(tid >> 6), lane = tid & 63, wr = wid >> 2, wc = wid & 3, fr = lane & 15, fq = lane >> 4;
    const int nt = K / BK;
    unsigned voffB[2]; int rowA[2]; unsigned colA[2];
#pragma unroll
    for (int i = 0; i < 2; ++i) { int R, C; stage_rc(tid * 16 + i * 8192, R, C); const int Rb = Epi::PERM ? ((R & ~31) + perm32(R & 31)) : R;
        rowA[i] = R; colA[i] = (unsigned)C * 2u; voffB[i] = (unsigned)(Rb * K + C) * 2u; }
    unsigned ca0[2], ca1[2], na0[2], na1[2];
#define PG8_ROWS(uu, d0, d1) do { const int cnt_ = seg[(uu).e]; _Pragma("unroll") for (int _i = 0; _i < 2; ++_i) { \
        int r0_ = (uu).pm * 256 + rowA[_i], r1_ = r0_ + 128; r0_ = r0_ < cnt_ ? r0_ : cnt_ - 1; r1_ = r1_ < cnt_ ? r1_ : cnt_ - 1; \
        (d0)[_i] = (unsigned)(list[(uu).e * NTOK + r0_] >> 1) * (unsigned)(K * 2) + colA[_i]; (d1)[_i] = (unsigned)(list[(uu).e * NTOK + r1_] >> 1) * (unsigned)(K * 2) + colA[_i]; } } while (0)
    const size_t kstep = (size_t)(BK * 2);
    const size_t hstep = (size_t)HALF * K * 2;
    const unsigned ldsw = (unsigned)wid * 1024u;
    const int aoff = lds_byte(wr * 64 + fr, fq * 8), boff = lds_byte(wc * 32 + fr, fq * 8);
#define PG8_SA(b, h) (((b) * 2 + (h)) * HTB)
#define PG8_SB(b, h) ((4 + (b) * 2 + (h)) * HTB)
#define PG8_STAGE(bufoff, gbase, voff) do { _Pragma("unroll") for (int _i = 0; _i < 2; ++_i) \
        __builtin_amdgcn_global_load_lds((const unsigned*)((const char*)(gbase) + (voff)[_i]), (LAS unsigned*)(lds + (bufoff) + ldsw + _i * 8192), 16, 0, 0); } while (0)
#define PG8_LDA(dst, b, h) do { _Pragma("unroll") for (int m = 0; m < 4; ++m) _Pragma("unroll") for (int k = 0; k < 2; ++k) dst[m][k] = *(const LAS bf16x8*)(lds + PG8_SA(b, h) + aoff + m * 2048 + k * 1024); } while (0)
#define PG8_LDB(dst, b, h) do { _Pragma("unroll") for (int n = 0; n < 2; ++n) _Pragma("unroll") for (int k = 0; k < 2; ++k) dst[n][k] = *(const LAS bf16x8*)(lds + PG8_SB(b, h) + boff + n * 2048 + k * 1024); } while (0)
#define PG8_MMA(ai, bj, At, Bt) do { __builtin_amdgcn_s_setprio(1); _Pragma("unroll") for (int m = 0; m < 4; ++m) _Pragma("unroll") for (int n = 0; n < 2; ++n) _Pragma("unroll") for (int k = 0; k < 2; ++k) \
        acc[ai][bj][m][n] = __builtin_amdgcn_mfma_f32_16x16x32_bf16(Bt[n][k], At[m][k], acc[ai][bj][m][n], 0, 0, 0); __builtin_amdgcn_s_setprio(0); } while (0)
#define PG8_WAIT_V(n) asm volatile("s_waitcnt vmcnt(" #n ")" ::: "memory")
#define PG8_WAIT_L(n) asm volatile("s_waitcnt lgkmcnt(" #n ")" ::: "memory")
#define PG8_BAR __builtin_amdgcn_s_barrier()
#define PG8_SCHED __builtin_amdgcn_sched_barrier(0)
    Unit cur, nxt, nxt2; int ui = 0;
    if (!S.next(0, cur)) return;
    f32x4 acc[2][2][4][2];
#pragma unroll
    for (int a = 0; a < 2; ++a)
#pragma unroll
        for (int b = 0; b < 2; ++b)
#pragma unroll
            for (int m = 0; m < 4; ++m)
#pragma unroll
                for (int n = 0; n < 2; ++n) acc[a][b][m][n] = (f32x4){0.f, 0.f, 0.f, 0.f};
    bf16x8 At[4][2], B0[2][2], B1[2][2];
    const char* cA = Ag; const char* cB = cur.b;
    bool has_next = S.next(1, nxt);
    PG8_ROWS(cur, ca0, ca1);
    if (has_next) PG8_ROWS(nxt, na0, na1); else { na0[0] = ca0[0]; na0[1] = ca0[1]; na1[0] = ca1[0]; na1[1] = ca1[1]; }
    asm volatile("" : "+v"(ca0[0]), "+v"(ca0[1]), "+v"(ca1[0]), "+v"(ca1[1]), "+v"(na0[0]), "+v"(na0[1]), "+v"(na1[0]), "+v"(na1[1]));
    PG8_STAGE(PG8_SB(0, 0), cB, voffB); PG8_STAGE(PG8_SB(0, 1), cB + hstep, voffB); PG8_STAGE(PG8_SA(0, 0), cA, ca0); PG8_STAGE(PG8_SA(0, 1), cA, ca1);
    if (wr == 1) PG8_BAR;
    PG8_WAIT_V(2); PG8_BAR;
    PG8_STAGE(PG8_SB(1, 0), cB + kstep, voffB); PG8_STAGE(PG8_SA(1, 0), cA + kstep, ca0); PG8_STAGE(PG8_SB(1, 1), cB + hstep + kstep, voffB);
    PG8_WAIT_V(6); PG8_BAR;
    for (;;) {
        const bool hi_on = cur.rows > 128;
        const char* nB = has_next ? nxt.b : cB;
        for (int t = 0; t < nt; t += 2) {
            const bool last = (t == nt - 2);
            const char* a1 = cA + (size_t)(t + 1) * kstep;
            const char* a2 = last ? cA : cA + (size_t)(t + 2) * kstep; const char* b2 = last ? nB : cB + (size_t)(t + 2) * kstep;
            unsigned x0[2], x1[2];
            x0[0] = last ? na0[0] : ca0[0]; x0[1] = last ? na0[1] : ca0[1]; x1[0] = last ? na1[0] : ca1[0]; x1[1] = last ? na1[1] : ca1[1];
            const char* a3 = a2 + kstep; const char* b3 = b2 + kstep;
            PG8_LDB(B0, 0, 0); PG8_LDB(B1, 0, 1); PG8_SCHED; PG8_LDA(At, 0, 0); PG8_STAGE(PG8_SA(1, 1), a1, ca1);
            PG8_WAIT_V(8); PG8_WAIT_L(0); PG8_BAR; PG8_MMA(0, 0, At, B0); PG8_MMA(0, 1, At, B1); PG8_BAR; PG8_SCHED;
            PG8_LDA(At, 0, 1); PG8_STAGE(PG8_SB(0, 0), b2, voffB); PG8_STAGE(PG8_SB(0, 1), b2 + hstep, voffB); PG8_STAGE(PG8_SA(0, 0), a2, x0);
            PG8_WAIT_V(8); PG8_WAIT_L(0); PG8_BAR; if (hi_on) { PG8_MMA(1, 0, At, B0); PG8_MMA(1, 1, At, B1); } PG8_BAR; PG8_SCHED;
            PG8_LDB(B0, 1, 0); PG8_LDB(B1, 1, 1); PG8_SCHED; PG8_LDA(At, 1, 0); PG8_STAGE(PG8_SA(0, 1), a2, x1);
            PG8_WAIT_V(8); PG8_WAIT_L(0); PG8_BAR; PG8_MMA(0, 0, At, B0); PG8_MMA(0, 1, At, B1); PG8_BAR; PG8_SCHED;
            PG8_LDA(At, 1, 1); PG8_STAGE(PG8_SB(1, 0), b3, voffB); PG8_STAGE(PG8_SB(1, 1), b3 + hstep, voffB); PG8_STAGE(PG8_SA(1, 0), a3, x0);
            PG8_WAIT_V(8); PG8_WAIT_L(0); PG8_BAR; if (hi_on) { PG8_MMA(1, 0, At, B0); PG8_MMA(1, 1, At, B1); } PG8_BAR; PG8_SCHED;
        }
        Unit nx2; const bool has_nx2 = has_next && S.next(ui + 2, nx2);
        if (has_nx2) PG8_ROWS(nx2, ca0, ca1); else { ca0[0] = na0[0]; ca0[1] = na0[1]; ca1[0] = na1[0]; ca1[1] = na1[1]; }
        if (wr == 0) PG8_BAR;
        E(acc, cur, wr, wc, fr, fq);
        asm volatile("" : "+v"(ca0[0]), "+v"(ca0[1]), "+v"(ca1[0]), "+v"(ca1[1]));
        if (!has_next) break;
        { unsigned t_; t_ = ca0[0]; ca0[0] = na0[0]; na0[0] = t_; t_ = ca0[1]; ca0[1] = na0[1]; na0[1] = t_; t_ = ca1[0]; ca1[0] = na1[0]; na1[0] = t_; t_ = ca1[1]; ca1[1] = na1[1]; na1[1] = t_; }
        has_next = has_nx2; if (has_nx2) nxt2 = nx2;
#pragma unroll
        for (int a = 0; a < 2; ++a)
#pragma unroll
            for (int b = 0; b < 2; ++b)
#pragma unroll
                for (int m = 0; m < 4; ++m)
#pragma unroll
                    for (int n = 0; n < 2; ++n) acc[a][b][m][n] = (f32x4){0.f, 0.f, 0.f, 0.f};
        cur = nxt; cB = nB; ++ui; nxt = nxt2;
        if (wr == 1) PG8_BAR;
    }
    PG8_WAIT_V(0);
    PG8_BAR;
#undef PG8_SA
#undef PG8_SB
#undef PG8_STAGE
#undef PG8_LDA
#undef PG8_LDB
#undef PG8_MMA
#undef PG8_WAIT_V
#undef PG8_WAIT_L
#undef PG8_BAR
#undef PG8_SCHED
#undef PG8_ROWS
}
}

struct EpiProj {
    static constexpr bool PERM = true;
    __device__ __forceinline__ void pre(LAS unsigned char*, const pg8::Unit&, int) const {}
    bf16_t* proj; const LAS float* gl;
    __device__ __forceinline__ void operator()(const f32x4 (&acc)[2][2][4][2], const pg8::Unit& u, int wr, int wc, int fr, int fq) const {
        const int slot = 4 * u.pn + wc, st = slot_type(slot);
        const bool nrm = (st == ST_QFOX || st == ST_KFOX || st == ST_QDIL || st == ST_KDIL);
        const LAS float* gp = gl + (st == ST_QFOX ? 0 : st == ST_KFOX ? 64 : st == ST_QDIL ? 128 : 192);
        const float sc = (st == ST_QFOX || st == ST_QDIL || st == ST_QSB) ? 0.125f * LOG2E : 1.f;
        f32x4 g[2][2];
#pragma unroll
        for (int bj = 0; bj < 2; ++bj)
#pragma unroll
            for (int n = 0; n < 2; ++n) g[bj][n] = nrm ? *(const LAS f32x4*)(gp + 32 * bj + 8 * fq + 4 * n) * sc : (f32x4){sc, sc, sc, sc};
        bf16_t* base = proj + ((size_t)slot * NTOK + (size_t)u.pm * 256 + wr * 64 + fr) * 64 + 8 * fq;
#pragma unroll
        for (int ai = 0; ai < 2; ++ai)
#pragma unroll
            for (int m = 0; m < 4; ++m) {
                f32x4 v[2][2];
#pragma unroll
                for (int bj = 0; bj < 2; ++bj)
#pragma unroll
                    for (int n = 0; n < 2; ++n) v[bj][n] = acc[ai][bj][m][n];
                float rstd = 1.f;
                if (nrm) {
                    float ss = 0.f;
#pragma unroll
                    for (int bj = 0; bj < 2; ++bj)
#pragma unroll
                        for (int n = 0; n < 2; ++n) ss += (v[bj][n][0] * v[bj][n][0] + v[bj][n][1] * v[bj][n][1]) + (v[bj][n][2] * v[bj][n][2] + v[bj][n][3] * v[bj][n][3]);
                    ss += __shfl_xor(ss, 16); ss += __shfl_xor(ss, 32);
                    rstd = rsqrtf(ss * (1.f / 64.f) + RMS_EPS);
                }
                if (st == ST_G) {
#pragma unroll
                    for (int bj = 0; bj < 2; ++bj)
#pragma unroll
                        for (int n = 0; n < 2; ++n)
#pragma unroll
                            for (int j = 0; j < 4; ++j) v[bj][n][j] = __builtin_amdgcn_rcpf(1.f + __expf(-v[bj][n][j]));
                }
                bf16_t* rowp = base + (size_t)(ai * 128 + m * 16) * 64;
#pragma unroll
                for (int bj = 0; bj < 2; ++bj) {
                    const f32x4 v0 = v[bj][0] * rstd * g[bj][0], v1 = v[bj][1] * rstd * g[bj][1];
                    u32x4 w; w.x = pg8::cvt_pk_bf16(v0[0], v0[1]); w.y = pg8::cvt_pk_bf16(v0[2], v0[3]); w.z = pg8::cvt_pk_bf16(v1[0], v1[1]); w.w = pg8::cvt_pk_bf16(v1[2], v1[3]);
                    *(u32x4*)(rowp + 32 * bj) = w;
                }
            }
    }
};
struct EpiOut {
    static constexpr bool PERM = true;
    __device__ __forceinline__ void pre(LAS unsigned char*, const pg8::Unit&, int) const {}
    const float* xin32; const bf16_t* xin16; bf16_t* out; const float* gm;
    __device__ __forceinline__ void operator()(const f32x4 (&acc)[2][2][4][2], const pg8::Unit& u, int wr, int wc, int fr, int fq) const {
        const int row0 = u.pm * 256 + wr * 64 + fr, col0 = u.pn * 256 + wc * 32 + 8 * fq, b = (u.pm * 256) / S;
        f32x4 gv[2][2];
#pragma unroll
        for (int bj = 0; bj < 2; ++bj)
#pragma unroll
            for (int n = 0; n < 2; ++n) gv[bj][n] = *(const f32x4*)(gm + (size_t)b * 6144 + col0 + bj * 128 + n * 4);
#define EO_OFF(it_) ((size_t)(row0 + ((it_) >> 3) * 128 + (((it_) >> 1) & 3) * 16) * D + col0 + ((it_) & 1) * 128)
        constexpr int PF = 4;
        if (xin32) {
            f32x4 xq[PF][2];
#pragma unroll
            for (int it = 0; it < PF; ++it) { xq[it][0] = __builtin_nontemporal_load((const f32x4*)(xin32 + EO_OFF(it))); xq[it][1] = __builtin_nontemporal_load((const f32x4*)(xin32 + EO_OFF(it) + 4)); }
#pragma unroll
            for (int it = 0; it < 16; ++it) {
                const int ai = it >> 3, m = (it >> 1) & 3, bj = it & 1;
                const f32x4 x0 = xq[it % PF][0], x1 = xq[it % PF][1];
                if (it + PF < 16) { xq[it % PF][0] = __builtin_nontemporal_load((const f32x4*)(xin32 + EO_OFF(it + PF))); xq[it % PF][1] = __builtin_nontemporal_load((const f32x4*)(xin32 + EO_OFF(it + PF) + 4)); }
                const f32x4 v0 = x0 + gv[bj][0] * acc[ai][bj][m][0], v1 = x1 + gv[bj][1] * acc[ai][bj][m][1];
                u32x4 w; w.x = pg8::cvt_pk_bf16(v0[0], v0[1]); w.y = pg8::cvt_pk_bf16(v0[2], v0[3]); w.z = pg8::cvt_pk_bf16(v1[0], v1[1]); w.w = pg8::cvt_pk_bf16(v1[2], v1[3]);
                *(u32x4*)(out + EO_OFF(it)) = w;
            }
        } else {
            u32x4 xq[PF];
#pragma unroll
            for (int it = 0; it < PF; ++it) xq[it] = __builtin_nontemporal_load((const u32x4*)(xin16 + EO_OFF(it)));
#pragma unroll
            for (int it = 0; it < 16; ++it) {
                const int ai = it >> 3, m = (it >> 1) & 3, bj = it & 1;
                const u32x4 xv = xq[it % PF];
                if (it + PF < 16) xq[it % PF] = __builtin_nontemporal_load((const u32x4*)(xin16 + EO_OFF(it + PF)));
                const f32x4 x0 = (f32x4){__uint_as_float(xv.x << 16), __uint_as_float(xv.x & 0xffff0000u), __uint_as_float(xv.y << 16), __uint_as_float(xv.y & 0xffff0000u)};
                const f32x4 x1 = (f32x4){__uint_as_float(xv.z << 16), __uint_as_float(xv.z & 0xffff0000u), __uint_as_float(xv.w << 16), __uint_as_float(xv.w & 0xffff0000u)};
                const f32x4 v0 = x0 + gv[bj][0] * acc[ai][bj][m][0], v1 = x1 + gv[bj][1] * acc[ai][bj][m][1];
                u32x4 w; w.x = pg8::cvt_pk_bf16(v0[0], v0[1]); w.y = pg8::cvt_pk_bf16(v0[2], v0[3]); w.z = pg8::cvt_pk_bf16(v1[0], v1[1]); w.w = pg8::cvt_pk_bf16(v1[2], v1[3]);
                *(u32x4*)(out + EO_OFF(it)) = w;
            }
        }
#undef EO_OFF
    }
};
struct EpiGU {
    static constexpr bool PERM = true;
    bf16_t* hid; const LAS int* seg;
    __device__ __forceinline__ void operator()(const f32x4 (&acc)[2][2][4][2], const pg8::Unit& u, int wr, int wc, int fr, int fq) const {
        bf16_t* base = hid + ((size_t)(seg[16 + u.e] + u.pm * 256 + wr * 64 + fr)) * DFF + u.pn * 128 + wc * 32 + 8 * fq;
#pragma unroll
        for (int ai = 0; ai < 2; ++ai)
#pragma unroll
            for (int m = 0; m < 4; ++m) {
                f32x4 h[2];
#pragma unroll
                for (int n = 0; n < 2; ++n)
#pragma unroll
                    for (int j = 0; j < 4; ++j) { const float gte = acc[ai][0][m][n][j]; h[n][j] = gte * __builtin_amdgcn_rcpf(1.f + __expf(-gte)) * acc[ai][1][m][n][j]; }
                u32x4 w; w.x = pg8::cvt_pk_bf16(h[0][0], h[0][1]); w.y = pg8::cvt_pk_bf16(h[0][2], h[0][3]); w.z = pg8::cvt_pk_bf16(h[1][0], h[1][1]); w.w = pg8::cvt_pk_bf16(h[1][2], h[1][3]);
                *(u32x4*)(base + (size_t)(ai * 128 + m * 16) * DFF) = w;
            }
    }
};
struct EpiDown {
    static constexpr bool PERM = true;
    bf16_t* yb; const int* list; const float* listw; const LAS int* seg; LAS unsigned char* ldsb;
    __device__ __forceinline__ void pre(LAS unsigned char* lds, const pg8::Unit& u, int tid) const {
        const int t = tid & 255, wv = __builtin_amdgcn_readfirstlane(tid >> 6);
        const void* src = tid < 256 ? (const void*)(list + u.e * NTOK + u.pm * 256 + t) : (const void*)(listw + u.e * NTOK + u.pm * 256 + t);
        lds_dma4(src, (unsigned)__builtin_amdgcn_readfirstlane((unsigned)(uintptr_t)lds + DNSL_OFF + u.par * 2048 + wv * 256));
    }
    __device__ __forceinline__ void operator()(const f32x4 (&acc)[2][2][4][2], const pg8::Unit& u, int wr, int wc, int fr, int fq) const {
        const int cnt = seg[u.e], col0 = u.pn * 256 + wc * 32 + 8 * fq;
        const LAS int* sl_e = (const LAS int*)(ldsb + DNSL_OFF + u.par * 2048); const LAS float* sl_g = (const LAS float*)(ldsb + DNSL_OFF + u.par * 2048 + 1024);
#pragma unroll
        for (int ai = 0; ai < 2; ++ai)
#pragma unroll
            for (int m = 0; m < 4; ++m) {
                const int ll = ai * 128 + wr * 64 + m * 16 + fr, lr = u.pm * 256 + ll;
                if (lr < cnt) {
                    const int ent = sl_e[ll]; const float gw = sl_g[ll];
                    bf16_t* rowp = yb + ((size_t)(ent & 1) * NTOK + (size_t)(ent >> 1)) * D + col0;
#pragma unroll
                    for (int bj = 0; bj < 2; ++bj) {
                        const f32x4 v0 = acc[ai][bj][m][0] * gw, v1 = acc[ai][bj][m][1] * gw;
                        u32x4 w; w.x = pg8::cvt_pk_bf16(v0[0], v0[1]); w.y = pg8::cvt_pk_bf16(v0[2], v0[3]); w.z = pg8::cvt_pk_bf16(v1[0], v1[1]); w.w = pg8::cvt_pk_bf16(v1[2], v1[3]);
                        *(u32x4*)(rowp + bj * 128) = w;
                    }
                }
            }
    }
};

struct PrepItem { const float* src; bf16_t* dst; int ldw, K; };
__device__ __forceinline__ PrepItem prep_decode(const Args& a, int l, int r) {
    constexpr int I_IN = 16 * 104, I_OUT = 16 * 32, I_GU = 16 * 16 * 32;
    PrepItem p;
    if (r < I_IN) {
        const int kb = r / 104, nb = r % 104, cp = nb * 32;
        const int lc = slot_col(4 * (cp >> 8) + ((cp >> 5) & 3)) + 32 * ((cp >> 7) & 1);
        p.src = a.in[I_WIN] + (size_t)l * D * IN_COLS + (size_t)kb * 64 * IN_COLS + lc; p.ldw = IN_COLS;
        p.dst = (bf16_t*)(a.ws + WS_WIN) + ((size_t)l * 3328 + cp) * D + kb * 64; p.K = D; return p;
    }
    r -= I_IN;
    if (r < I_OUT) {
        const int kb = r / 32, nb = r % 32;
        p.src = a.in[I_WOUT] + (size_t)l * D * D + (size_t)kb * 64 * D + nb * 32; p.ldw = D;
        p.dst = (bf16_t*)(a.ws + WS_WOUT) + ((size_t)l * D + nb * 32) * D + kb * 64; p.K = D; return p;
    }
    r -= I_OUT;
    if (r < I_GU) {
        const int e = r / 512, r2 = r % 512, kb = r2 / 32, nb = r2 % 32, pn = nb >> 3, bj = (nb >> 2) & 1, sub = nb & 3;
        p.src = a.in[bj ? I_WU : I_WG] + ((size_t)l * NE + e) * D * DFF + (size_t)kb * 64 * DFF + 128 * pn + 32 * sub; p.ldw = DFF;
        p.dst = (bf16_t*)(a.ws + WS_WGU) + (((size_t)l * NE + e) * 1024 + nb * 32) * D + kb * 64; p.K = D; return p;
    }
    r -= I_GU;
    { const int e = r / 256, r2 = r % 256, kb = r2 / 32, nb = r2 % 32;
      p.src = a.in[I_WD] + ((size_t)l * NE + e) * DFF * D + (size_t)kb * 64 * D + nb * 32; p.ldw = D;
      p.dst = (bf16_t*)(a.ws + WS_WDN) + (((size_t)l * NE + e) * 1024 + nb * 32) * DFF + kb * 64; p.K = DFF; return p; }
}
__device__ __forceinline__ void p0_prep(const Args& a, LAS unsigned char* lds, int l, int blk0, int nblk, int it_lo = 0, int it_hi = 16 * 104 + 16 * 32 + 16 * 16 * 32 + 16 * 8 * 32) {
    const int tid = opaque_tid(), lane = tid & 63, wave = tid >> 6;
    LAS float* scr = (LAS float*)(lds + 49152) + wave * (64 * 33);
    const int gw = ((int)blockIdx.x - blk0) * NWAVES + wave, ngw = nblk * NWAVES;
    constexpr int I_L = 16 * 104 + 16 * 32 + 16 * 16 * 32 + 16 * 8 * 32;
    if ((int)blockIdx.x < blk0 || (int)blockIdx.x >= blk0 + nblk) return;
    float tv[32];
    const int I_E = it_hi < I_L ? it_hi : I_L;
    int it = it_lo + gw;
    if (it < I_E) { const PrepItem p = prep_decode(a, l, it);
#pragma unroll
        for (int i = 0; i < 32; ++i) tv[i] = __builtin_nontemporal_load(p.src + (size_t)(2 * i + (lane >> 5)) * p.ldw + (lane & 31)); }
    for (; it < I_E; it += ngw) {
        const PrepItem p = prep_decode(a, l, it);
#pragma unroll
        for (int i = 0; i < 32; ++i) scr[(2 * i + (lane >> 5)) * 33 + (lane & 31)] = tv[i];
        if (it + ngw < I_E) { const PrepItem q = prep_decode(a, l, it + ngw);
#pragma unroll
            for (int i = 0; i < 32; ++i) tv[i] = __builtin_nontemporal_load(q.src + (size_t)(2 * i + (lane >> 5)) * q.ldw + (lane & 31)); }
        asm volatile("s_waitcnt lgkmcnt(0)" ::: "memory");
        const int c = lane & 7;
#pragma unroll
        for (int j = 0; j < 4; ++j) { const int n = (lane >> 3) + 8 * j; const LAS float* sp = scr + (8 * c) * 33 + n;
            u32x4 o; o.x = pk2(sp[0 * 33], sp[1 * 33]); o.y = pk2(sp[2 * 33], sp[3 * 33]); o.z = pk2(sp[4 * 33], sp[5 * 33]); o.w = pk2(sp[6 * 33], sp[7 * 33]);
            *(u32x4*)(p.dst + (size_t)n * p.K + 8 * c) = o; }
        asm volatile("s_waitcnt lgkmcnt(0)" ::: "memory");
    }
}

__device__ __forceinline__ void p0_mod(const Args& a, LAS unsigned char* lds) {
    LAS float* cs = (LAS float*)lds;
    LAS float* red = (LAS float*)(lds + 32768);
    const int tid = opaque_tid();
    const float* c = a.in[I_C];
    {
        float cv[16];
#pragma unroll
        for (int k = 0; k < 16; ++k) cv[k] = c[tid + k * NTHR];
#pragma unroll
        for (int k = 0; k < 16; ++k) cs[tid + k * NTHR] = cv[k] / (1.f + expf(-cv[k]));
    }
    __syncthreads();
    float* mod = (float*)(a.ws + WS_MOD);
    const int dch = tid >> 5, el = tid & 31;
    for (int u = blockIdx.x; u < NL * 192; u += gridDim.x) {
        const int l = u / 192, e0 = (u % 192) * 32;
        const float* w = a.in[I_ADAW] + (size_t)l * D * 6144 + e0 + el;
        float acc[8];
#pragma unroll
        for (int b = 0; b < 8; ++b) acc[b] = 0.f;
#pragma unroll 1
        for (int d0 = dch * 64; d0 < dch * 64 + 64; d0 += 16) {
            float wv[16];
#pragma unroll
            for (int k = 0; k < 16; ++k) wv[k] = __builtin_nontemporal_load(w + (size_t)(d0 + k) * 6144);
#pragma unroll
            for (int k = 0; k < 16; ++k)
#pragma unroll
                for (int b = 0; b < 8; ++b) acc[b] += cs[b * D + d0 + k] * wv[k];
        }
#pragma unroll
        for (int b = 0; b < 8; ++b) red[(dch * 32 + el) * 8 + b] = acc[b];
        __syncthreads();
        if (tid < 256) {
            const int e2 = tid & 31, b = tid >> 5; float s = 0.f;
            for (int k = 0; k < 16; ++k) s += red[(k * 32 + e2) * 8 + b];
            mod[((size_t)l * NB + b) * 6144 + e0 + e2] = s + a.in[I_ADAB][l * 6144 + e0 + e2];
        }
        __syncthreads();
    }
}

__device__ __forceinline__ f32x4 bf4_lo(const u32x4& v) { return (f32x4){__uint_as_float(v.x << 16), __uint_as_float(v.x & 0xffff0000u), __uint_as_float(v.y << 16), __uint_as_float(v.y & 0xffff0000u)}; }
__device__ __forceinline__ f32x4 bf4_hi(const u32x4& v) { return (f32x4){__uint_as_float(v.z << 16), __uint_as_float(v.z & 0xffff0000u), __uint_as_float(v.w << 16), __uint_as_float(v.w & 0xffff0000u)}; }
__device__ __forceinline__ void n1_norm(const Args& a, LAS unsigned char* lds, int layer, bool dry = false) {
    LAS float* wf = (LAS float*)lds;
    const int tid = opaque_tid(), lane = tid & 63, wave = tid >> 6;
    const float* win = a.in[I_WIN] + (size_t)layer * D * IN_COLS;
    {
        float wv[8];
#pragma unroll
        for (int k = 0; k < 8; ++k) { const int i = tid + k * NTHR; wv[k] = win[(size_t)(i >> 2) * IN_COLS + 1024 + (i & 3)]; }
#pragma unroll
        for (int k = 0; k < 8; ++k) wf[tid + k * NTHR] = wv[k];
    }
    __syncthreads();
    const float* mod = (const float*)(a.ws + WS_MOD);
    const float* nm = a.in[I_NMIX] + layer * D;
    bf16_t* act = (bf16_t*)(a.ws + WS_ACT);
    float* flog = (float*)(a.ws + WS_FLOG);
    const bf16_t* yb = (const bf16_t*)(a.ws + WS_YBUF);
    const int gw = blockIdx.x * NWAVES + wave, ngw = gridDim.x * NWAVES;
    for (int rg = gw; rg < NTOK / 16; rg += ngw) {
        const int row0 = rg * 16, b = row0 / S;
        const float* sh = mod + ((size_t)layer * NB + b) * 6144;
        const float* sc = sh + 1024;
        const float* gf = mod + ((size_t)(layer > 0 ? layer - 1 : 0) * NB + b) * 6144 + 5120;
        f32x4 ga[4], s0v[4], gfv[4];
#pragma unroll
        for (int j = 0; j < 4; ++j) { const int col = 8 * lane + 512 * (j >> 1) + 4 * (j & 1);
            ga[j] = *(const f32x4*)(nm + col) * (1.f + *(const f32x4*)(sc + col)); s0v[j] = *(const f32x4*)(sh + col); gfv[j] = *(const f32x4*)(gf + col); }
        u32x4 nb[2][6];
#define N1_LOAD(s_, r_) do { if (layer == 0) { const float* xin_ = a.in[I_X] + (size_t)(r_) * D; _Pragma("unroll") for (int j = 0; j < 4; ++j) nb[s_][j] = __builtin_nontemporal_load((const u32x4*)(xin_ + 8 * lane + 512 * (j >> 1) + 4 * (j & 1))); } \
        else { _Pragma("unroll") for (int jp = 0; jp < 2; ++jp) { const size_t o_ = (size_t)(r_) * D + 8 * lane + 512 * jp; \
            nb[s_][3 * jp] = __builtin_nontemporal_load((const u32x4*)((const bf16_t*)(a.ws + WS_XB) + o_)); nb[s_][3 * jp + 1] = __builtin_nontemporal_load((const u32x4*)(yb + o_)); nb[s_][3 * jp + 2] = __builtin_nontemporal_load((const u32x4*)(yb + (size_t)NTOK * D + o_)); } } } while (0)
        N1_LOAD(0, row0); N1_LOAD(1, row0 + 1);
#pragma unroll 1
        for (int i = 0; i < 16; i += 2) {
            f32x4 v[2][4];
#pragma unroll
            for (int q2 = 0; q2 < 2; ++q2) {
                if (layer == 0) {
#pragma unroll
                    for (int j = 0; j < 4; ++j) v[q2][j] = __builtin_bit_cast(f32x4, nb[q2][j]);
                } else {
#pragma unroll
                    for (int jp = 0; jp < 2; ++jp) {
                        v[q2][2 * jp] = bf4_lo(nb[q2][3 * jp]) + gfv[2 * jp] * (bf4_lo(nb[q2][3 * jp + 1]) + bf4_lo(nb[q2][3 * jp + 2]));
                        v[q2][2 * jp + 1] = bf4_hi(nb[q2][3 * jp]) + gfv[2 * jp + 1] * (bf4_hi(nb[q2][3 * jp + 1]) + bf4_hi(nb[q2][3 * jp + 2]));
                    }
                }
            }
            if (i < 14) { N1_LOAD(0, row0 + i + 2); N1_LOAD(1, row0 + i + 3); }
            float ss[2], fl[2][4];
#pragma unroll
            for (int q2 = 0; q2 < 2; ++q2) {
                const int row = row0 + i + q2;
                if (layer > 0 && !dry) {
                    bf16_t* xb = (bf16_t*)(a.ws + WS_XB) + (size_t)row * D;
#pragma unroll
                    for (int jp = 0; jp < 2; ++jp) { u32x4 xo; xo.x = pk2(v[q2][2 * jp].x, v[q2][2 * jp].y); xo.y = pk2(v[q2][2 * jp].z, v[q2][2 * jp].w); xo.z = pk2(v[q2][2 * jp + 1].x, v[q2][2 * jp + 1].y); xo.w = pk2(v[q2][2 * jp + 1].z, v[q2][2 * jp + 1].w);
                        *(u32x4*)(xb + 8 * lane + 512 * jp) = xo; }
                }
                ss[q2] = 0.f;
#pragma unroll
                for (int j = 0; j < 4; ++j) ss[q2] += v[q2][j].x * v[q2][j].x + v[q2][j].y * v[q2][j].y + v[q2][j].z * v[q2][j].z + v[q2][j].w * v[q2][j].w;
            }
#pragma unroll
            for (int o2 = 1; o2 < 64; o2 <<= 1) { ss[0] += __shfl_xor(ss[0], o2); ss[1] += __shfl_xor(ss[1], o2); }
#pragma unroll
            for (int q2 = 0; q2 < 2; ++q2) {
                const int row = row0 + i + q2;
                const float rstd = rsqrtf(ss[q2] * (1.f / D) + RMS_EPS);
#pragma unroll
                for (int q = 0; q < 4; ++q) fl[q2][q] = 0.f;
#pragma unroll
                for (int jp = 0; jp < 2; ++jp) {
                    f32x4 h[2];
#pragma unroll
                    for (int k = 0; k < 2; ++k) {
                        const int col = 8 * lane + 512 * jp + 4 * k;
                        h[k] = v[q2][2 * jp + k] * rstd * ga[2 * jp + k] + s0v[2 * jp + k];
#pragma unroll
                        for (int q = 0; q < 4; ++q) fl[q2][q] += h[k].x * wf[(col + 0) * 4 + q] + h[k].y * wf[(col + 1) * 4 + q] + h[k].z * wf[(col + 2) * 4 + q] + h[k].w * wf[(col + 3) * 4 + q];
                    }
                    u32x4 o; o.x = pk2(h[0].x, h[0].y); o.y = pk2(h[0].z, h[0].w); o.z = pk2(h[1].x, h[1].y); o.w = pk2(h[1].z, h[1].w);
                    *(u32x4*)(act + (size_t)row * D + 8 * lane + 512 * jp) = o;
                }
            }
#pragma unroll
            for (int o2 = 1; o2 < 64; o2 <<= 1) {
#pragma unroll
                for (int q = 0; q < 4; ++q) { fl[0][q] += __shfl_xor(fl[0][q], o2); fl[1][q] += __shfl_xor(fl[1][q], o2); }
            }
            if (lane < 8) {
                const int q2 = lane >> 2, q = lane & 3;
                const float f = q2 == 0 ? (q == 0 ? fl[0][0] : q == 1 ? fl[0][1] : q == 2 ? fl[0][2] : fl[0][3]) : (q == 0 ? fl[1][0] : q == 1 ? fl[1][1] : q == 2 ? fl[1][2] : fl[1][3]);
                flog[(size_t)(row0 + i + q2) * 4 + q] = log_sigmoid_f(f + a.in[I_BFORGET][layer * 4 + q]);
            }
        }
#undef N1_LOAD
    }
    __syncthreads();
}


__device__ __forceinline__ int t5_bucket(int dist) {
    if (dist < 16) return dist;
    int b = 16;
    b += dist >= 22; b += dist >= 30; b += dist >= 40; b += dist >= 54; b += dist >= 73; b += dist >= 99; b += dist >= 134; b += dist >= 182;
    b += dist >= 246; b += dist >= 332; b += dist >= 450; b += dist >= 609; b += dist >= 825; b += dist >= 1117; b += dist >= 1513;
    return b;
}


__device__ __forceinline__ void n2_glds16(const void* gsrc, unsigned lds_dst) { unsigned keep;
    asm volatile("s_mov_b32 %0, m0\n\ts_mov_b32 m0, %2\n\ts_nop 0\n\tglobal_load_lds_dwordx4 %1, off\n\ts_mov_b32 m0, %0" : "=&s"(keep) : "v"(gsrc), "s"(lds_dst) : "memory"); }
__device__ __forceinline__ void n2_mfma(const Args& a, LAS unsigned char* lds, int layer) {
    LAS float* WgL = (LAS float*)lds;
    LAS float* lgw = (LAS float*)(lds + 65536);
    LAS int* pe = (LAS int*)(lds + 73728);
    LAS float* pg = (LAS float*)(lds + 74752);
    LAS int* sbase = (LAS int*)(lds + 76800);
    LAS int* wtot = (LAS int*)(lds + 77056);
    LAS float* gaL = (LAS float*)(lds + 77824); LAS float* s0L = gaL + 1024;
    LAS float* ceL = (LAS float*)(lds + 86016);
    LAS float* cpart = (LAS float*)(lds + 86080);
    constexpr int N2_BUF = 89088;
    const int tid = opaque_tid(), wave = __builtin_amdgcn_readfirstlane(tid >> 6);
    const float* mod = (const float*)(a.ws + WS_MOD);
    const float* nf = a.in[I_NFFN] + layer * D;
    bf16_t* act = (bf16_t*)(a.ws + WS_ACT);
    unsigned* cnt = (unsigned*)(a.ws + WS_CTL) + CW_CNT + layer * 16 * 64;
    int* list = (int*)(a.ws + WS_LIST);
    float* listw = (float*)(a.ws + WS_LISTW);
    const unsigned l0 = (unsigned)(uintptr_t)lds;
    for (int rblk = blockIdx.x; rblk < NTOK / 128; rblk += gridDim.x) {
        const int row0 = rblk * 128 + wave * 16, b = (rblk * 128) / S;
        const float* sh = mod + ((size_t)layer * NB + b) * 6144 + 3072;
        const float* sc = sh + 1024;
        __syncthreads();
        int lane_ = tid & 63; asm volatile("" : "+v"(lane_));
        const int r = lane_ & 15, g = lane_ >> 4;
        const bf16_t* xbase = (const bf16_t*)(a.ws + WS_XB) + (size_t)row0 * D;
        const int dr0 = lane_ >> 3, dr1 = 8 + (lane_ >> 3);
        const bf16_t* src0 = xbase + (size_t)dr0 * D + 8 * ((lane_ & 7) ^ ((dr0 >> 1) & 7));
        const bf16_t* src1 = xbase + (size_t)dr1 * D + 8 * ((lane_ & 7) ^ ((dr1 >> 1) & 7));
        const unsigned bufw = l0 + N2_BUF + wave * 6144;
#define N2_DMA(c) do { const unsigned d_ = (unsigned)__builtin_amdgcn_readfirstlane(bufw + ((c) % 3) * 2048); n2_glds16(src0 + (c) * 64, d_); n2_glds16(src1 + (c) * 64, d_ + 1024); } while (0)
        N2_DMA(0); N2_DMA(1);
        for (int i = tid; i < D; i += NTHR) { gaL[i] = nf[i] * (1.f + sc[i]); s0L[i] = sh[i]; }
        __syncthreads();
        {
            int ts = tid; asm volatile("" : "+v"(ts));
            const int e = ts & 15, part = ts >> 4;
            float cs = 0.f;
            float wv[32];
#pragma unroll
            for (int t = 0; t < 32; ++t) wv[t] = a.in[I_RW][(part * 32 + t) * 16 + e];
#pragma unroll
            for (int t = 0; t < 32; ++t) {
                const int col = part * 32 + t;
                const float w = wv[t];
                const int c = col >> 6, p8 = (col >> 3) & 7, j = col & 7, g = p8 & 3, ii = p8 >> 2, q = 2 * ii + (j >> 2), jj = j & 3;
                WgL[(((c * 4 + g) * 4 + q) * 16 + e) * 4 + jj] = w * gaL[col];
                cs += w * s0L[col];
            }
            cpart[part * 16 + e] = cs;
        }
        __syncthreads();
        if (tid < 16) { float t = 0.f; for (int k = 0; k < 32; ++k) t += cpart[k * 16 + tid]; ceL[tid] = t; }
        __syncthreads();
        const LAS unsigned char* rdb = lds + N2_BUF + wave * 6144 + r * 128;
        const int sw = (r >> 1) & 7;
        const int sl0 = 16 * (g ^ sw), sl1 = 16 * ((g + 4) ^ sw);
        u32x4 xs[32];
        f32x4 acc0 = (f32x4){0.f, 0.f, 0.f, 0.f}, acc1 = (f32x4){0.f, 0.f, 0.f, 0.f};
        float ss = 0.f;
#pragma unroll
        for (int c = 0; c < 16; ++c) {
            asm volatile("s_waitcnt lgkmcnt(0)" ::: "memory");
            if (c + 2 < 16) { N2_DMA(c + 2); asm volatile("s_waitcnt vmcnt(4)" ::: "memory"); }
            else if (c + 1 < 16) asm volatile("s_waitcnt vmcnt(2)" ::: "memory");
            else asm volatile("s_waitcnt vmcnt(0)" ::: "memory");
            const LAS unsigned char* cb = rdb + (c % 3) * 2048;
            xs[2 * c] = *(const LAS u32x4*)(cb + sl0);
            xs[2 * c + 1] = *(const LAS u32x4*)(cb + sl1);
            const LAS f32x4* wq = (const LAS f32x4*)(WgL + ((c * 4) * 4 * 16) * 4) + (g * 4) * 16 + r;
            f32x4 w0 = wq[0], w1 = wq[16], w2 = wq[32], w3 = wq[48];
#pragma unroll
            for (int k = 0; k < 4; ++k) {
                const unsigned v0 = xs[2 * c][k], v1 = xs[2 * c + 1][k];
                const float x00 = __uint_as_float(v0 << 16), x01 = __uint_as_float(v0 & 0xffff0000u);
                const float x10 = __uint_as_float(v1 << 16), x11 = __uint_as_float(v1 & 0xffff0000u);
                ss += x00 * x00 + x01 * x01; ss += x10 * x10 + x11 * x11;
                const float wa = (k < 2 ? w0 : w1)[2 * (k & 1)], wb = (k < 2 ? w0 : w1)[2 * (k & 1) + 1];
                const float wc = (k < 2 ? w2 : w3)[2 * (k & 1)], wd = (k < 2 ? w2 : w3)[2 * (k & 1) + 1];
                acc0 = __builtin_amdgcn_mfma_f32_16x16x4f32(wa, x00, acc0, 0, 0, 0);
                acc1 = __builtin_amdgcn_mfma_f32_16x16x4f32(wc, x10, acc1, 0, 0, 0);
                acc0 = __builtin_amdgcn_mfma_f32_16x16x4f32(wb, x01, acc0, 0, 0, 0);
                acc1 = __builtin_amdgcn_mfma_f32_16x16x4f32(wd, x11, acc1, 0, 0, 0);
            }
            __builtin_amdgcn_sched_barrier(0);
        }
#undef N2_DMA
        ss += __shfl_xor(ss, 16); ss += __shfl_xor(ss, 32);
        const float rstd = rsqrtf(ss * (1.f / D) + RMS_EPS);
#pragma unroll
        for (int i = 0; i < 32; ++i) asm volatile("" : "+v"(xs[i]));
        int lane_b = tid & 63; asm volatile("" : "+v"(lane_b));
        const int rb_ = lane_b & 15, gb_ = lane_b >> 4;
        {
            const f32x4 ce4 = *(const LAS f32x4*)(ceL + 4 * gb_);
            *(LAS f32x4*)(lgw + (wave * 16 + rb_) * 16 + 4 * gb_) = (acc0 + acc1) * rstd + ce4;
        }
        bf16_t* arow = act + (size_t)(row0 + rb_) * D + 8 * gb_;
#pragma unroll
        for (int c = 0; c < 16; ++c)
#pragma unroll
            for (int i = 0; i < 2; ++i) {
                const int col0 = 64 * c + 32 * i;
                const LAS f32x4* gp = (const LAS f32x4*)(gaL + col0) + 2 * gb_; const LAS f32x4* sp = (const LAS f32x4*)(s0L + col0) + 2 * gb_;
                const f32x4 ga0 = gp[0] * rstd, ga1 = gp[1] * rstd, s00 = sp[0], s01 = sp[1];
                const u32x4 xv = xs[2 * c + i];
                const f32x4 h0 = bf4_lo(xv) * ga0 + s00, h1 = bf4_hi(xv) * ga1 + s01;
                u32x4 o; o.x = pk2(h0.x, h0.y); o.y = pk2(h0.z, h0.w); o.z = pk2(h1.x, h1.y); o.w = pk2(h1.z, h1.w);
                *(u32x4*)(arow + col0) = o;
                __builtin_amdgcn_sched_barrier(0);
            }
        asm volatile("s_waitcnt lgkmcnt(0)" ::: "memory");
        int lane_c = tid & 63; asm volatile("" : "+v"(lane_c));
        if (lane_c < 16) {
            const int lane = lane_c;
            float lg[16];
#pragma unroll
            for (int q = 0; q < 4; ++q) { const f32x4 t4 = *(const LAS f32x4*)(lgw + (wave * 16 + lane) * 16 + 4 * q); const f32x4 rb4 = *(const f32x4*)(a.in[I_RB] + 4 * q);
                lg[4 * q] = t4.x + rb4.x; lg[4 * q + 1] = t4.y + rb4.y; lg[4 * q + 2] = t4.z + rb4.z; lg[4 * q + 3] = t4.w + rb4.w; }
            float mx = lg[0];
#pragma unroll
            for (int e = 1; e < 16; ++e) mx = fmaxf(mx, lg[e]);
            float p[16], sum = 0.f;
#pragma unroll
            for (int e = 0; e < 16; ++e) { p[e] = expf(lg[e] - mx); sum += p[e]; }
            const float inv = 1.f / sum;
#pragma unroll
            for (int e = 0; e < 16; ++e) p[e] *= inv;
            int bg = 0, bi0 = 0, bi1 = 1; float bscore = -1.f, bp0 = 0.f, bp1 = 0.f;
#pragma unroll
            for (int gq = 0; gq < 4; ++gq) {
                int i0 = 0; float p0 = p[4 * gq];
#pragma unroll
                for (int k = 1; k < 4; ++k) if (p[4 * gq + k] > p0) { p0 = p[4 * gq + k]; i0 = k; }
                int i1 = -1; float p1 = -1.f;
#pragma unroll
                for (int k = 0; k < 4; ++k) if (k != i0 && p[4 * gq + k] > p1) { p1 = p[4 * gq + k]; i1 = k; }
                const float sc2 = p0 + p1;
                if (sc2 > bscore) { bscore = sc2; bg = gq; bi0 = i0; bi1 = i1; bp0 = p0; bp1 = p1; }
            }
            const float gs = 1.f / (bp0 + bp1);
            const int pi = (wave * 16 + lane) * 2;
            pe[pi] = bg * 4 + bi0; pg[pi] = bp0 * gs; pe[pi + 1] = bg * 4 + bi1; pg[pi + 1] = bp1 * gs;
        }
        __syncthreads();
        int my_e = 0, my_rank = 0;
        int tq = tid; asm volatile("" : "+v"(tq));
        if (tq < 256) {
            my_e = pe[tq];
#pragma unroll
            for (int e = 0; e < 16; ++e) {
                const unsigned long long m = __ballot(my_e == e);
                if (my_e == e) my_rank = __popcll(m & ((1ull << (tq & 63)) - 1ull));
                if ((tq & 63) == 0) wtot[(tq >> 6) * 16 + e] = __popcll(m);
            }
        }
        __syncthreads();
        if (tq < 16) {
            const int c0 = wtot[tq], c1 = wtot[16 + tq], c2 = wtot[32 + tq], c3 = wtot[48 + tq], c = c0 + c1 + c2 + c3;
            const int base = c ? (int)__hip_atomic_fetch_add(cnt + tq * 64, (unsigned)c, __ATOMIC_RELAXED, __HIP_MEMORY_SCOPE_AGENT) : 0;
            sbase[tq] = base; sbase[16 + tq] = base + c0; sbase[32 + tq] = base + c0 + c1; sbase[48 + tq] = base + c0 + c1 + c2;
        }
        __syncthreads();
        if (tq < 256) {
            const int pos = sbase[(tq >> 6) * 16 + my_e] + my_rank;
            list[my_e * NTOK + pos] = (rblk * 128 + (tq >> 1)) * 2 + (tq & 1); listw[my_e * NTOK + pos] = pg[tq];
        }
        __syncthreads();
    }
}

__device__ __forceinline__ void fin_combine(const Args& a, int layer, float* outp = nullptr) {
    const float* mod = (const float*)(a.ws + WS_MOD);
    const bf16_t* yb = (const bf16_t*)(a.ws + WS_YBUF);
    const bf16_t* xb = (const bf16_t*)(a.ws + WS_XB);
    float* out = outp ? outp : a.out;
    const size_t n8 = (size_t)NTOK * D / 8, step = (size_t)gridDim.x * NTHR;
    const int tid = opaque_tid();
    for (size_t i0 = (size_t)blockIdx.x * NTHR + tid; i0 < n8; i0 += 4 * step) {
        u32x4 xv[4], y0[4], y1[4];
#pragma unroll
        for (int k = 0; k < 4; ++k) { const size_t i = i0 + k * step; if (i < n8) { const size_t e0 = i * 8;
            xv[k] = __builtin_nontemporal_load((const u32x4*)(xb + e0)); y0[k] = __builtin_nontemporal_load((const u32x4*)(yb + e0)); y1[k] = __builtin_nontemporal_load((const u32x4*)(yb + (size_t)NTOK * D + e0)); } }
#pragma unroll
        for (int k = 0; k < 4; ++k) { const size_t i = i0 + k * step; if (i < n8) { const size_t e0 = i * 8; const int row = (int)(e0 / D), col = (int)(e0 % D), b = row / S;
            const float* gp = mod + ((size_t)layer * NB + b) * 6144 + 5120 + col;
            const f32x4 g0 = *(const f32x4*)gp, g1 = *(const f32x4*)(gp + 4);
            __builtin_nontemporal_store(bf4_lo(xv[k]) + g0 * (bf4_lo(y0[k]) + bf4_lo(y1[k])), (f32x4*)(out + e0));
            __builtin_nontemporal_store(bf4_hi(xv[k]) + g1 * (bf4_hi(y0[k]) + bf4_hi(y1[k])), (f32x4*)(out + e0 + 4)); } }
    }
}


namespace att {
typedef short bf16x8 __attribute__((ext_vector_type(8)));
typedef short s16x4 __attribute__((ext_vector_type(4)));
typedef float f32x16 __attribute__((ext_vector_type(16)));
constexpr int L_K = 0, L_V = 49152, L_OST = 98304, L_CK = 135168, L_FLAG = 136192, L_INFO = 136448, L_TAB = 136704;
constexpr int OST_PITCH = 144;
__device__ __forceinline__ int crow(int r, int hi) { return (r & 3) + 8 * (r >> 2) + 4 * hi; }
typedef float f32x2_t __attribute__((ext_vector_type(2))); typedef __bf16 bf16x2_t __attribute__((ext_vector_type(2)));
__device__ __forceinline__ unsigned cvtpk(float lo, float hi) { f32x2_t v = {lo, hi}; bf16x2_t b = __builtin_convertvector(v, bf16x2_t); return __builtin_bit_cast(unsigned, b); }
__device__ __forceinline__ float other_half_sum(float v) {
    auto rr = __builtin_amdgcn_permlane32_swap(__float_as_uint(v), __float_as_uint(v), false, false);
    return __uint_as_float(rr[0]) + __uint_as_float(rr[1]);
}
__device__ __forceinline__ float other_half_max(float v) {
    auto rr = __builtin_amdgcn_permlane32_swap(__float_as_uint(v), __float_as_uint(v), false, false);
    return fmaxf(__uint_as_float(rr[0]), __uint_as_float(rr[1]));
}
__device__ __forceinline__ void glds16(const void* gsrc, unsigned lds_dst) { unsigned keep;
    asm volatile("s_mov_b32 %0, m0\n\ts_mov_b32 m0, %2\n\ts_nop 0\n\tglobal_load_lds_dwordx4 %1, off\n\ts_mov_b32 m0, %0" : "=&s"(keep) : "v"(gsrc), "s"(lds_dst) : "memory"); }
__device__ __forceinline__ void glds4(const void* gsrc, unsigned lds_dst) { unsigned keep;
    asm volatile("s_mov_b32 %0, m0\n\ts_mov_b32 m0, %2\n\ts_nop 0\n\tglobal_load_lds_dword %1, off\n\ts_mov_b32 m0, %0" : "=&s"(keep) : "v"(gsrc), "s"(lds_dst) : "memory"); }
__device__ __forceinline__ void dma_kv(LAS unsigned char* lds, int buf, const bf16_t* Kt, const bf16_t* Vt, size_t rowstride, int wid, int lane) {
    const int krow = 8 * wid + (lane >> 3), kch = (lane & 7) ^ ((krow >> 1) & 7);
    const bf16_t* ks = Kt + (size_t)krow * rowstride + kch * 8;
    const bf16_t* vs = Vt + (size_t)(16 * (wid & 3) + (lane >> 2)) * rowstride + (wid >> 2) * 32 + (lane & 3) * 8;
    const unsigned l0 = (unsigned)(uintptr_t)lds;
    glds16(ks, (unsigned)__builtin_amdgcn_readfirstlane(l0 + L_K + buf * 8192 + wid * 1024));
    glds16(vs, (unsigned)__builtin_amdgcn_readfirstlane(l0 + L_V + buf * 8192 + wid * 1024));
}
__device__ __forceinline__ void qkt(f32x16& p0, f32x16& p1, const LAS unsigned char* Kb, const bf16x8 (&qr)[4], float cinit, int r32, int hi) {
    const int sw = (r32 >> 1) & 7;
    bf16x8 kf[8];
#pragma unroll
    for (int d0 = 0; d0 < 4; ++d0) {
        unsigned ka = (unsigned)(uintptr_t)Kb + r32 * 128 + (((2 * d0 + hi) ^ sw) << 4); asm volatile("" : "+v"(ka));
        kf[2 * d0] = *(const LAS bf16x8*)(uintptr_t)ka;
        kf[2 * d0 + 1] = *(const LAS bf16x8*)(uintptr_t)(ka + 4096);
    }
#pragma unroll
    for (int r = 0; r < 16; ++r) { p0[r] = cinit; p1[r] = cinit; }
    __builtin_amdgcn_sched_barrier(0);
#pragma unroll
    for (int d0 = 0; d0 < 4; ++d0) {
        p0 = __builtin_amdgcn_mfma_f32_32x32x16_bf16(kf[2 * d0], qr[d0], p0, 0, 0, 0);
        p1 = __builtin_amdgcn_mfma_f32_32x32x16_bf16(kf[2 * d0 + 1], qr[d0], p1, 0, 0, 0);
    }
}
typedef short v4i16_t __attribute__((ext_vector_type(4)));
__device__ __forceinline__ s16x4 vtr(const LAS unsigned char* p) { return __builtin_bit_cast(s16x4, __builtin_amdgcn_ds_read_tr16_b64_v4i16((LAS v4i16_t*)p)); }
__device__ __forceinline__ void pv(f32x16 (&o)[2], const f32x16& p0, const f32x16& p1, const LAS unsigned char* Vb, int lane) {
    const int hi = lane >> 5;
    unsigned va = (unsigned)(uintptr_t)Vb + ((lane >> 4) & 1) * 32 + (lane & 3) * 8 + (4 * hi + ((lane & 15) >> 2)) * 64; asm volatile("" : "+v"(va));
    const LAS unsigned char* vp = (const LAS unsigned char*)(uintptr_t)va;
    s16x4 vlo[8], vhh[8];
#pragma unroll
    for (int i = 0; i < 8; ++i) { vlo[i] = vtr(vp + (i >> 2) * 4096 + (i & 3) * 1024); vhh[i] = vtr(vp + (i >> 2) * 4096 + (i & 3) * 1024 + 512); }
    u32x4 pw[4];
    pw[0] = (u32x4){cvtpk(p0[0], p0[1]), cvtpk(p0[2], p0[3]), cvtpk(p0[4], p0[5]), cvtpk(p0[6], p0[7])};
    pw[1] = (u32x4){cvtpk(p0[8], p0[9]), cvtpk(p0[10], p0[11]), cvtpk(p0[12], p0[13]), cvtpk(p0[14], p0[15])};
    pw[2] = (u32x4){cvtpk(p1[0], p1[1]), cvtpk(p1[2], p1[3]), cvtpk(p1[4], p1[5]), cvtpk(p1[6], p1[7])};
    pw[3] = (u32x4){cvtpk(p1[8], p1[9]), cvtpk(p1[10], p1[11]), cvtpk(p1[12], p1[13]), cvtpk(p1[14], p1[15])};
    __builtin_amdgcn_sched_barrier(0);
#pragma unroll
    for (int d0 = 0; d0 < 2; ++d0)
#pragma unroll
        for (int ks = 0; ks < 4; ++ks) {
            const s16x4 lo = vlo[4 * d0 + ks], hh = vhh[4 * d0 + ks];
            const bf16x8 vf = (bf16x8){lo[0], lo[1], lo[2], lo[3], hh[0], hh[1], hh[2], hh[3]};
            o[d0] = __builtin_amdgcn_mfma_f32_32x32x16_bf16(vf, __builtin_bit_cast(bf16x8, pw[ks]), o[d0], 0, 0, 0);
        }
}
__device__ __forceinline__ void exp_sum(f32x16& p0, f32x16& p1, float& l_part) {
    float rs = 0.f;
#pragma unroll
    for (int r = 0; r < 16; ++r) { p0[r] = __builtin_amdgcn_exp2f(p0[r]); p1[r] = __builtin_amdgcn_exp2f(p1[r]); rs += p0[r] + p1[r]; }
    l_part += rs;
}
__device__ __forceinline__ void online_step(f32x16& p0, f32x16& p1, float& m_run, float& l_part, f32x16 (&o)[2]) {
    float mt = fmaxf(p0[0], p1[0]);
#pragma unroll
    for (int r = 1; r < 16; ++r) mt = fmaxf(mt, fmaxf(p0[r], p1[r]));
    mt = other_half_max(mt);
    const float mn = fmaxf(m_run, mt);
    const float msafe = mn == -INFINITY ? 0.f : mn;
    const float f = __builtin_amdgcn_exp2f(m_run - msafe);
    float rs = 0.f;
#pragma unroll
    for (int r = 0; r < 16; ++r) { p0[r] = __builtin_amdgcn_exp2f(p0[r] - msafe); p1[r] = __builtin_amdgcn_exp2f(p1[r] - msafe); rs += p0[r] + p1[r]; }
    l_part = l_part * f + rs; m_run = mn;
#pragma unroll
    for (int r = 0; r < 16; ++r) { o[0][r] *= f; o[1][r] *= f; }
}
template <class RowPtr, class GatePtr>
__device__ __forceinline__ void store_o(const f32x16 (&o)[2], float scale, LAS unsigned char* lds, int wid, int lane, const RowPtr& rowp, const GatePtr& gatep, bool has_gate) {
    const int r32 = lane & 31, hi = lane >> 5;
    LAS unsigned char* stg = lds + L_OST + wid * (32 * OST_PITCH);
    u32x4 gv[4];
    if (has_gate) {
#pragma unroll
        for (int i = 0; i < 4; ++i) gv[i] = *(const u32x4*)(gatep(i * 8 + (lane >> 3)) + (lane & 7) * 8);
    }
#pragma unroll
    for (int d0 = 0; d0 < 2; ++d0)
#pragma unroll
        for (int g = 0; g < 4; ++g) {
            u32x2 w; w.x = cvtpk(o[d0][4 * g] * scale, o[d0][4 * g + 1] * scale); w.y = cvtpk(o[d0][4 * g + 2] * scale, o[d0][4 * g + 3] * scale);
            *(LAS u32x2*)(stg + r32 * OST_PITCH + (32 * d0 + 8 * g + 4 * hi) * 2) = w;
        }
    asm volatile("s_waitcnt lgkmcnt(0)" ::: "memory");
#pragma unroll
    for (int i = 0; i < 4; ++i) {
        const int row = i * 8 + (lane >> 3), ch = lane & 7;
        u32x4 v = *(const LAS u32x4*)(stg + row * OST_PITCH + ch * 16);
        if (has_gate) {
#pragma unroll
            for (int k = 0; k < 4; ++k) {
                const float a0 = __uint_as_float(v[k] << 16) * __uint_as_float(gv[i][k] << 16), a1 = __uint_as_float(v[k] & 0xffff0000u) * __uint_as_float(gv[i][k] & 0xffff0000u);
                v[k] = cvtpk(a0, a1);
            }
        }
        *(u32x4*)(rowp(row) + ch * 8) = v;
    }
    asm volatile("s_waitcnt lgkmcnt(0)" ::: "memory");
}
}

constexpr int AT_NFOX = 512, AT_NDIL = 2304, AT_NSB = 768, AT_NUNITS = AT_NFOX + AT_NDIL + AT_NSB;
#define AT_DIL_SPLIT 1
constexpr int CW_QUEUE = 20480;

__device__ __forceinline__ void at_mfma(const Args& a, LAS unsigned char* lds, int layer, int qslot = 0, int kmask = 7, int dbg = 0) {
    using namespace att;
    const int tid = opaque_tid(), wid = __builtin_amdgcn_readfirstlane(tid >> 6);
    const bf16_t* proj = (const bf16_t*)(a.ws + WS_PROJ);
    bf16_t* mix = (bf16_t*)(a.ws + WS_ACT);
    bf16_t* dilo = (bf16_t*)a.out;
    float* dill = (float*)(a.ws + WS_DILL);
    const float* cumall = (const float*)(a.ws + WS_CUM);
    unsigned* queue = (unsigned*)(a.ws + WS_CTL) + CW_QUEUE + (layer + 2 * qslot) * 64;
    LAS int* flags = (LAS int*)(lds + L_FLAG);
    LAS int* info = (LAS int*)(lds + L_INFO);
    LAS float* tab = (LAS float*)(lds + L_TAB);
    LAS float* relb = (LAS float*)(lds + SEG_OFF + 256);
    if (tid < 32 * 6) relb[tid] = a.in[I_RELB][tid] * LOG2E;
    __syncthreads();
    float bfox, bdil, bmax;
    { const int l64 = tid & 63;
      float g0 = fabsf(a.in[I_QGF][layer * 64 + l64]), g1 = fabsf(a.in[I_KGF][layer * 64 + l64]), g2 = fabsf(a.in[I_QGD][layer * 64 + l64]), g3 = fabsf(a.in[I_KGD][layer * 64 + l64]);
      float rbm = 0.f;
      for (int i = l64; i < 32 * 6; i += 64) rbm = fmaxf(rbm, a.in[I_RELB][i]);
#pragma unroll
      for (int o2 = 1; o2 < 64; o2 <<= 1) { g0 = fmaxf(g0, __shfl_xor(g0, o2)); g1 = fmaxf(g1, __shfl_xor(g1, o2)); g2 = fmaxf(g2, __shfl_xor(g2, o2)); g3 = fmaxf(g3, __shfl_xor(g3, o2)); rbm = fmaxf(rbm, __shfl_xor(rbm, o2)); }
      bfox = 8.f * g0 * g1 * LOG2E * 1.01f; bdil = 8.f * g2 * g3 * LOG2E * 1.01f; bmax = fmaxf(rbm, 0.f) * LOG2E; }
    const float fox_thr = 152.f + 2.f * bfox;
    const bool fox_fixed = bfox < 40.f, dil_fixed = (bdil + bmax) < 40.f;
    const float m_dil = bdil + bmax;
    const unsigned l0 = (unsigned)(uintptr_t)lds;
#define AT_WAIT_BAR(NI, n) do { if ((n) >= 2) asm volatile("s_waitcnt vmcnt(%0) lgkmcnt(0)\n\ts_barrier" :: "n"(2 * (NI)) : "memory"); \
        else if ((n) == 1) asm volatile("s_waitcnt vmcnt(%0) lgkmcnt(0)\n\ts_barrier" :: "n"(NI) : "memory"); \
        else asm volatile("s_waitcnt vmcnt(0) lgkmcnt(0)\n\ts_barrier" ::: "memory"); } while (0)
#define FOX_ISSUE(i) do { const int j_ = jhi - (i), bf_ = (i) & 3; dma_kv(lds, bf_, Kb + (size_t)j_ * 4096, Vb + (size_t)j_ * 4096, 64, wid, lane); \
        glds4(cum + j_ * 64 + lane, (unsigned)__builtin_amdgcn_readfirstlane(l0 + L_CK + bf_ * 256)); } while (0)
#define SB_ISSUE(i) do { const int j_ = jhi - (i); dma_kv(lds, (i) & 3, Kb + (size_t)j_ * 4096, Vb + (size_t)j_ * 4096, 64, wid, lane); } while (0)
#define UNIT_ON(u_) ((u_) < AT_NFOX ? (MF_FOX && (kmask & 1)) : (u_) < AT_NFOX + AT_NDIL ? (MF_DIL && (kmask & 2)) : (MF_SB && (kmask & 4)))

    bf16x8 qr[4];
    float fox_cr = 0.f, fox_cv = 0.f, fox_cq = 0.f;
    auto prologue = [&](int u) {
        if (!UNIT_ON(u)) return;
        int lane = tid & 63; asm volatile("" : "+v"(lane));
        const int r32 = lane & 31, hi = lane >> 5;
        if (u < AT_NFOX) {
            const int qb = 15 - (u >> 5), bh = u & 31, b = bh >> 2, h = bh & 3, q0 = qb * 256;
            const size_t rb = (size_t)b * S;
            const bf16_t* Kb = proj + ((size_t)(4 + h) * NTOK + rb) * 64;
            const bf16_t* Vb = proj + ((size_t)(8 + h) * NTOK + rb) * 64;
            const float* cum = cumall + (size_t)bh * S;
            const int jhi = 4 * qb + 3;
            fox_cr = cum[q0]; fox_cv = cum[64 * (lane <= jhi ? lane : jhi) + 63]; fox_cq = cum[q0 + 32 * wid + r32];
            if (!(dbg & 1)) { FOX_ISSUE(0); FOX_ISSUE(1); FOX_ISSUE(2); }
            const bf16_t* Q = proj + ((size_t)(0 + h) * NTOK + rb + q0 + 32 * wid + r32) * 64;
#pragma unroll
            for (int d0 = 0; d0 < 4; ++d0) qr[d0] = *(const bf16x8*)(Q + d0 * 16 + hi * 8);
        } else if (u < AT_NFOX + AT_NDIL) {
            const int v2 = u - AT_NFOX, bh = v2 % 48, rest = v2 / 48, b = bh / 6, h = bh % 6, p = rest >> 4, x = rest & 15;
            const int dil = p == 0 ? 1 : p == 1 ? 4 : 16, res = x % dil, nb2 = x / dil;
            const size_t rb = (size_t)b * S;
            const bf16_t* Kb = proj + ((size_t)(22 + h) * NTOK + rb) * 64;
            const bf16_t* Vb = proj + ((size_t)(28 + h) * NTOK + rb) * 64;
            const int mk_base = 256 * nb2 - 128, tt_lo = nb2 == 0 ? 2 : 0;
            const size_t rs = (size_t)64 * dil;
#pragma unroll
            for (int tt = 5; tt >= 0; --tt) if (tt >= tt_lo && !(dbg & 1)) dma_kv(lds, tt, Kb + ((size_t)(mk_base + 64 * tt) * dil + res) * 64, Vb + ((size_t)(mk_base + 64 * tt) * dil + res) * 64, rs, wid, lane);
            if (tid < 256) { const int st = tid - 64; tab[tid] = (st >= 0 && st <= 128) ? relb[t5_bucket(st * dil) * 6 + h] : -INFINITY; }
            const size_t trow = (size_t)(256 * nb2 + 32 * wid + r32) * dil + res;
            const bf16_t* Q = proj + ((size_t)(16 + h) * NTOK + rb + trow) * 64;
#pragma unroll
            for (int d0 = 0; d0 < 4; ++d0) qr[d0] = *(const bf16x8*)(Q + d0 * 16 + hi * 8);
        } else {
            const int v2 = u - AT_NFOX - AT_NDIL, qb = 15 - v2 / 48, bh = v2 % 48, b = bh / 6, h = bh % 6, q0 = qb * 256;
            const size_t rb = (size_t)b * S;
            const bf16_t* Kb = proj + ((size_t)(40 + h) * NTOK + rb) * 64;
            const bf16_t* Vb = proj + ((size_t)(46 + h) * NTOK + rb) * 64;
            const int jhi = (q0 + 254) >> 6;
            if (!(dbg & 1)) { SB_ISSUE(0); SB_ISSUE(1); SB_ISSUE(2); }
            const bf16_t* Q = proj + ((size_t)(34 + h) * NTOK + rb + q0 + 32 * wid + r32) * 64;
#pragma unroll
            for (int d0 = 0; d0 < 4; ++d0) qr[d0] = *(const bf16x8*)(Q + d0 * 16 + hi * 8);
        }
    };

#define AT_QMAP(q_) ((q_) < AT_NFOX ? (q_) : (q_) + (AT_DIL_SPLIT ? AT_NDIL : 0))
    int u = AT_QMAP((int)blockIdx.x);
    if (u < AT_NUNITS) prologue(u);
    bool prev_st = false;
    while (u < AT_NUNITS) {
        if (prev_st) asm volatile("s_waitcnt vmcnt(4) lgkmcnt(0)\n\ts_barrier" ::: "memory");
        else asm volatile("s_waitcnt vmcnt(0) lgkmcnt(0)\n\ts_barrier" ::: "memory");
        int lane_ = tid & 63; asm volatile("" : "+v"(lane_));
        const int lane = lane_, r32 = lane & 31, hi = lane >> 5;
        asm volatile("" : "+v"(qr[0]), "+v"(qr[1]), "+v"(qr[2]), "+v"(qr[3]), "+v"(fox_cr), "+v"(fox_cv), "+v"(fox_cq));
        unsigned nextu = 0;
        if (tid == 0) nextu = __hip_atomic_fetch_add(queue, 1u, __ATOMIC_RELAXED, __HIP_MEMORY_SCOPE_AGENT) + gridDim.x;
        f32x16 o[2]; o[0] = (f32x16){}; o[1] = (f32x16){};
        const bool on = UNIT_ON(u);
        float oscale = 1.f, lse = 0.f;
        if (on && !(dbg & 2)) {
        if (u < AT_NFOX) {
            const int qb = 15 - (u >> 5), bh = u & 31, b = bh >> 2, h = bh & 3, q0 = qb * 256;
            const size_t rb = (size_t)b * S;
            const bf16_t* Kb = proj + ((size_t)(4 + h) * NTOK + rb) * 64;
            const bf16_t* Vb = proj + ((size_t)(8 + h) * NTOK + rb) * 64;
            const float* cum = cumall + (size_t)bh * S;
            const int jhi = 4 * qb + 3;
            const int tw = q0 + 32 * wid, t = tw + r32;
            const int jhi_w = (tw + 31) >> 6;
            const int ndead = __popcll(__ballot((lane <= jhi) && ((fox_cr - fox_cv) * LOG2E < -fox_thr)));
            const int T = jhi - ndead + 1;
            const float cinit = fox_fixed ? fox_cq * LOG2E - bfox : 0.f;
            float m_run = -INFINITY, l_part = 0.f;
            int issued = 3;
            for (int i = 0; i < T; ++i) {
                if (i > 0) { const int n = issued - 1 - i; AT_WAIT_BAR(3, n); }
                if (issued < T) { FOX_ISSUE(issued); ++issued; }
                const int j = jhi - i, buf = i & 3;
                if (j <= jhi_w) {
                    f32x16 p0, p1;
                    qkt(p0, p1, lds + L_K + buf * 8192, qr, cinit, r32, hi);
                    const LAS float* ck = (const LAS float*)(lds + L_CK + buf * 256);
                    const bool diag = (64 * j + 63 > tw);
#define FOX_BIAS(MASKED) _Pragma("unroll") for (int g = 0; g < 4; ++g) { \
                        const f32x4 c0 = *(const LAS f32x4*)(ck + 8 * g + 4 * hi), c1 = *(const LAS f32x4*)(ck + 32 + 8 * g + 4 * hi); \
                        _Pragma("unroll") for (int jj = 0; jj < 4; ++jj) { const int r = 4 * g + jj, s0 = 64 * j + crow(r, hi); \
                            p0[r] = fmaf(c0[jj], -LOG2E, p0[r]); p1[r] = fmaf(c1[jj], -LOG2E, p1[r]); \
                            if (MASKED) { if (s0 > t) p0[r] = -INFINITY; if (s0 + 32 > t) p1[r] = -INFINITY; } } }
                    if (diag) { asm volatile("; forgetting attention: diagonal tile (masked)" ::: "memory"); FOX_BIAS(true) } else { FOX_BIAS(false) }
#undef FOX_BIAS
                    if (fox_fixed) exp_sum(p0, p1, l_part); else online_step(p0, p1, m_run, l_part, o);
                    pv(o, p0, p1, lds + L_V + buf * 8192, lane);
                }
            }
            oscale = 1.f / other_half_sum(l_part);
        } else if (u < AT_NFOX + AT_NDIL) {
            const int v2 = u - AT_NFOX, rest = v2 / 48, x = rest & 15, p = rest >> 4;
            const int dil = p == 0 ? 1 : p == 1 ? 4 : 16, nb2 = x / dil;
            const int tt_lo = nb2 == 0 ? 2 : 0;
            const int twlo = wid >> 1;
            const float cinit = dil_fixed ? -m_dil : 0.f;
            float m_run = -INFINITY, l_part = 0.f;
#pragma unroll 1
            for (int tt = twlo + 2; tt >= twlo; --tt) {
                if (tt < tt_lo) break;
                f32x16 p0, p1;
                qkt(p0, p1, lds + L_K + tt * 8192, qr, cinit, r32, hi);
                const LAS float* tb = tab + (32 * wid + r32 + 192 - 64 * tt - 4 * hi - 63);
#pragma unroll
                for (int r = 0; r < 16; ++r) { p0[r] += tb[63 - crow(r, 0)]; p1[r] += tb[31 - crow(r, 0)]; }
                if (dil_fixed) exp_sum(p0, p1, l_part); else online_step(p0, p1, m_run, l_part, o);
                pv(o, p0, p1, lds + L_V + tt * 8192, lane);
            }
            const float l_run = other_half_sum(l_part);
            oscale = 1.f / l_run; lse = ((dil_fixed ? m_dil : m_run) + __builtin_amdgcn_logf(l_run)) * LN2;
        } else {
            const int v2 = u - AT_NFOX - AT_NDIL, qb = 15 - v2 / 48, bh = v2 % 48, b = bh / 6, h = bh % 6, q0 = qb * 256;
            const size_t rb = (size_t)b * S;
            const bf16_t* Kb = proj + ((size_t)(40 + h) * NTOK + rb) * 64;
            const bf16_t* Vb = proj + ((size_t)(46 + h) * NTOK + rb) * 64;
            const int tw = q0 + 32 * wid, t = tw + r32;
            const int jhi = (q0 + 254) >> 6, jhi_w = (tw + 30) >> 6, T = jhi + 1;
            float P_run = 1.f; bool wdone = false;
            int issued = 3; bool alldone = false;
            for (int i = 0; i < T; ++i) {
                if (i > 0) {
                    const int n = issued - 1 - i; AT_WAIT_BAR(2, n);
                    int c = 0;
#pragma unroll
                    for (int k = 0; k < 8; ++k) c += flags[((i - 1) & 1) * 8 + k];
                    alldone = (c == 8);
                }
                if (alldone) break;
                if (issued < T) { SB_ISSUE(issued); ++issued; }
                const int j = jhi - i, buf = i & 3;
                if (j <= jhi_w && !wdone) {
                    f32x16 p0, p1;
                    qkt(p0, p1, lds + L_K + buf * 8192, qr, 0.f, r32, hi);
                    const bool diag = (64 * j + 63 >= tw);
                    float gp[8];
#define SB_GROUPS(MASKED) _Pragma("unroll") for (int blk = 0; blk < 2; ++blk) _Pragma("unroll") for (int g = 0; g < 4; ++g) { float s4 = 1.f; \
                        _Pragma("unroll") for (int jj = 3; jj >= 0; --jj) { const int r = 4 * g + jj, s0 = 64 * j + 32 * blk + crow(r, hi); \
                            const float e = __builtin_amdgcn_exp2f(blk ? p1[r] : p0[r]); \
                            float keep = __builtin_amdgcn_rcpf(1.f + e); \
                            if (MASKED) { if (s0 >= t) keep = 1.f; } \
                            const float s4n = s4 * keep;                         \
                            if (blk) p1[r] = s4 - s4n; else p0[r] = s4 - s4n; \
                            s4 = s4n; } \
                        gp[4 * blk + g] = s4; }
                    if (diag) { asm volatile("; stick-breaking: diagonal tile (masked)" ::: "memory"); SB_GROUPS(true) } else { SB_GROUPS(false) }
#undef SB_GROUPS
                    float pt = P_run;
#pragma unroll
                    for (int k = 7; k >= 0; --k) {
                        auto rr = __builtin_amdgcn_permlane32_swap(__float_as_uint(gp[k]), __float_as_uint(gp[k]), false, false);
                        const float lo = __uint_as_float(rr[0]), up = __uint_as_float(rr[1]);
                        const float mul = hi == 0 ? pt * up : pt;
                        const int blk = k >> 2, g = k & 3;
#pragma unroll
                        for (int jj = 0; jj < 4; ++jj) { const int r = 4 * g + jj; if (blk) p1[r] *= mul; else p0[r] *= mul; }
                        pt *= lo * up;
                    }
                    P_run = pt;
                    pv(o, p0, p1, lds + L_V + buf * 8192, lane);
                    wdone = __all(P_run < 1.1754944e-38f);
                }
                if (lane == 0) flags[(i & 1) * 8 + wid] = wdone ? 1 : 0;
            }
        }
        }
        if (tid == 0) info[1] = AT_QMAP((int)nextu);
        asm volatile("s_waitcnt vmcnt(0) lgkmcnt(0)\n\ts_barrier" ::: "memory");
        const int un = info[1];
        if (un < AT_NUNITS) prologue(un);
        if (on && !(dbg & 4)) {
            if (u < AT_NFOX) {
                const int qb = 15 - (u >> 5), bh = u & 31, b = bh >> 2, h = bh & 3, tw = qb * 256 + 32 * wid;
                const size_t rb = (size_t)b * S;
                const bf16_t* G = proj + ((size_t)(12 + h) * NTOK + rb + tw) * 64;
                bf16_t* O = mix + ((size_t)h * NTOK + rb + tw) * 64;
                store_o(o, oscale, lds, wid, lane, [&](int row) { return O + (size_t)row * 64; }, [&](int row) { return G + (size_t)row * 64; }, true);
            } else if (u < AT_NFOX + AT_NDIL) {
                const int v2 = u - AT_NFOX, bh = v2 % 48, rest = v2 / 48, b = bh / 6, h = bh % 6, p = rest >> 4, x = rest & 15;
                const int dil = p == 0 ? 1 : p == 1 ? 4 : 16, res = x % dil, nb2 = x / dil;
                const size_t rb = (size_t)b * S;
                const int mw = 256 * nb2 + 32 * wid;
                bf16_t* O = dilo + (((size_t)p * 6 + h) * NTOK + rb) * 64;
                const size_t mw_row = (size_t)mw * dil + res;
                store_o(o, oscale, lds, wid, lane, [&](int row) { return O + (mw_row + (size_t)row * dil) * 64; }, [&](int row) { return (const bf16_t*)nullptr; }, false);
                if (hi == 0) dill[((size_t)p * 6 + h) * NTOK + rb + (size_t)(mw + r32) * dil + res] = lse;
            } else {
                const int v2 = u - AT_NFOX - AT_NDIL, qb = 15 - v2 / 48, bh = v2 % 48, b = bh / 6, h = bh % 6, tw = qb * 256 + 32 * wid;
                const size_t rb = (size_t)b * S;
                bf16_t* O = mix + ((size_t)(10 + h) * NTOK + rb + tw) * 64;
                store_o(o, 1.f, lds, wid, lane, [&](int row) { return O + (size_t)row * 64; }, [&](int row) { return (const bf16_t*)nullptr; }, false);
            }
        }
        prev_st = on && !(dbg & 4);
        u = un;
    }
    asm volatile("s_waitcnt vmcnt(0) lgkmcnt(0)\n\ts_barrier" ::: "memory");
#undef AT_QMAP
#undef AT_WAIT_BAR
#undef FOX_ISSUE
#undef SB_ISSUE
#undef UNIT_ON
}

__device__ __forceinline__ void att_pv_packed(att::f32x16 (&o)[2], const u32x4 (&pw)[4], const LAS unsigned char* Vb, int lane) {
    using namespace att;
    const int hi = lane >> 5;
    unsigned va = (unsigned)(uintptr_t)Vb + ((lane >> 4) & 1) * 32 + (lane & 3) * 8 + (4 * hi + ((lane & 15) >> 2)) * 64; asm volatile("" : "+v"(va));
    const LAS unsigned char* vp = (const LAS unsigned char*)(uintptr_t)va;
    s16x4 vlo[8], vhh[8];
#pragma unroll
    for (int i = 0; i < 8; ++i) { vlo[i] = vtr(vp + (i >> 2) * 4096 + (i & 3) * 1024); vhh[i] = vtr(vp + (i >> 2) * 4096 + (i & 3) * 1024 + 512); }
    __builtin_amdgcn_sched_barrier(0);
#pragma unroll
    for (int d0 = 0; d0 < 2; ++d0)
#pragma unroll
        for (int ks = 0; ks < 4; ++ks) {
            const s16x4 lo = vlo[4 * d0 + ks], hh = vhh[4 * d0 + ks];
            const bf16x8 vf = (bf16x8){lo[0], lo[1], lo[2], lo[3], hh[0], hh[1], hh[2], hh[3]};
            o[d0] = __builtin_amdgcn_mfma_f32_32x32x16_bf16(vf, __builtin_bit_cast(bf16x8, pw[ks]), o[d0], 0, 0, 0);
        }
}

__device__ __forceinline__ void at_dil(const Args& a, LAS unsigned char* lds, int layer) {
    using namespace att;
    const int tid = opaque_tid(), wid = __builtin_amdgcn_readfirstlane(tid >> 6);
    const bf16_t* proj = (const bf16_t*)(a.ws + WS_PROJ);
    bf16_t* dilo = (bf16_t*)a.out;
    float* dill = (float*)(a.ws + WS_DILL);
    unsigned* queue = (unsigned*)(a.ws + WS_CTL) + CW_QUEUE + (layer + 4) * 64;
    LAS int* info = (LAS int*)(lds + L_INFO);
    LAS float* tab = (LAS float*)(lds + L_TAB);
    LAS float* relb = (LAS float*)(lds + SEG_OFF + 256);
    float bdil, bmax;
    { const int l64 = tid & 63;
      float g2 = fabsf(a.in[I_QGD][layer * 64 + l64]), g3 = fabsf(a.in[I_KGD][layer * 64 + l64]);
      float rbm = 0.f;
      for (int i = l64; i < 32 * 6; i += 64) rbm = fmaxf(rbm, a.in[I_RELB][i]);
#pragma unroll
      for (int o2 = 1; o2 < 64; o2 <<= 1) { g2 = fmaxf(g2, __shfl_xor(g2, o2)); g3 = fmaxf(g3, __shfl_xor(g3, o2)); rbm = fmaxf(rbm, __shfl_xor(rbm, o2)); }
      bdil = 8.f * g2 * g3 * LOG2E * 1.01f; bmax = fmaxf(rbm, 0.f) * LOG2E; }
    const bool dil_fixed = (bdil + bmax) < 40.f;
    const float m_dil = bdil + bmax;
    const unsigned l0 = (unsigned)(uintptr_t)lds;
    __syncthreads();
    if (tid < 32 * 6) relb[tid] = a.in[I_RELB][tid] * LOG2E;
    if (tid == 0) info[1] = (int)__hip_atomic_fetch_add(queue, 2u, __ATOMIC_RELAXED, __HIP_MEMORY_SCOPE_AGENT);
    __syncthreads();

    bf16x8 qr[4];
    auto issue_k = [&](int v) {
        int lane = tid & 63; asm volatile("" : "+v"(lane));
        const int r32 = lane & 31, hi = lane >> 5;
        const int bh = v % 48, rest = v / 48, b = bh / 6, h = bh % 6, p = rest >> 4, x = rest & 15;
        const int dil = p == 0 ? 1 : p == 1 ? 4 : 16, res = x % dil, nb2 = x / dil;
        const size_t rb = (size_t)b * S;
        const bf16_t* Kb = proj + ((size_t)(22 + h) * NTOK + rb) * 64;
        const int mk_base = 256 * nb2 - 128, tt_lo = nb2 == 0 ? 2 : 0;
        const size_t rs = (size_t)64 * dil;
        const int krow = 8 * wid + (lane >> 3), kch = (lane & 7) ^ ((krow >> 1) & 7);
#pragma unroll
        for (int tt = 5; tt >= 0; --tt) if (tt >= tt_lo)
            glds16(Kb + ((size_t)(mk_base + 64 * tt) * dil + res) * 64 + (size_t)krow * rs + kch * 8, (unsigned)__builtin_amdgcn_readfirstlane(l0 + L_K + tt * 8192 + wid * 1024));
        if (tid < 256) { const int st = tid - 64; tab[tid] = (st >= 0 && st <= 128) ? relb[t5_bucket(st * dil) * 6 + h] : -INFINITY; }
        const size_t trow = (size_t)(256 * nb2 + 32 * wid + r32) * dil + res;
        const bf16_t* Q = proj + ((size_t)(16 + h) * NTOK + rb + trow) * 64;
#pragma unroll
        for (int d0 = 0; d0 < 4; ++d0) qr[d0] = *(const bf16x8*)(Q + d0 * 16 + hi * 8);
    };
    auto issue_v = [&](int v) {
        int lane = tid & 63; asm volatile("" : "+v"(lane));
        const int bh = v % 48, rest = v / 48, b = bh / 6, h = bh % 6, p = rest >> 4, x = rest & 15;
        const int dil = p == 0 ? 1 : p == 1 ? 4 : 16, res = x % dil, nb2 = x / dil;
        const bf16_t* Vb = proj + ((size_t)(28 + h) * NTOK + (size_t)b * S) * 64;
        const int mk_base = 256 * nb2 - 128, tt_lo = nb2 == 0 ? 2 : 0;
        const size_t rs = (size_t)64 * dil;
#pragma unroll
        for (int tt = 5; tt >= 0; --tt) if (tt >= tt_lo)
            glds16(Vb + ((size_t)(mk_base + 64 * tt) * dil + res) * 64 + (size_t)(16 * (wid & 3) + (lane >> 2)) * rs + (wid >> 2) * 32 + (lane & 3) * 8, (unsigned)__builtin_amdgcn_readfirstlane(l0 + L_V + tt * 8192 + wid * 1024));
    };

    int u = info[1], un = u + 1;
    if (u < AT_NDIL) issue_k(u);
    bool prev_st = false;
    while (u < AT_NDIL) {
        const int rest = u / 48, x = rest & 15, p = rest >> 4, bh = u % 48, b = bh / 6, h = bh % 6;
        const int dil = p == 0 ? 1 : p == 1 ? 4 : 16, res = x % dil, nb2 = x / dil;
        const int tt_lo = nb2 == 0 ? 2 : 0;
        if (prev_st) asm volatile("s_waitcnt vmcnt(5) lgkmcnt(0)\n\ts_barrier" ::: "memory"); else asm volatile("s_waitcnt vmcnt(0) lgkmcnt(0)\n\ts_barrier" ::: "memory");
        int lane_ = tid & 63; asm volatile("" : "+v"(lane_));
        const int lane = lane_, r32 = lane & 31, hi = lane >> 5;
        asm volatile("" : "+v"(qr[0]), "+v"(qr[1]), "+v"(qr[2]), "+v"(qr[3]));
        issue_v(u);
        unsigned nextu = 0;
        if (tid == 0) nextu = __hip_atomic_fetch_add(queue, 1u, __ATOMIC_RELAXED, __HIP_MEMORY_SCOPE_AGENT);
        const int twlo = wid >> 1;
        u32x4 pw[3][4];
        float l_part = 0.f, m_run = -INFINITY;
        if (dil_fixed) {
#pragma unroll
            for (int j = 0; j < 3; ++j) {
                const int tt = twlo + 2 - j;
                if (tt >= tt_lo) {
                    f32x16 p0, p1;
                    qkt(p0, p1, lds + L_K + tt * 8192, qr, -m_dil, r32, hi);
                    const LAS float* tb = tab + (32 * wid + r32 + 192 - 64 * tt - 4 * hi - 63);
#pragma unroll
                    for (int r = 0; r < 16; ++r) { p0[r] += tb[63 - crow(r, 0)]; p1[r] += tb[31 - crow(r, 0)]; }
                    exp_sum(p0, p1, l_part);
                    pw[j][0] = (u32x4){cvtpk(p0[0], p0[1]), cvtpk(p0[2], p0[3]), cvtpk(p0[4], p0[5]), cvtpk(p0[6], p0[7])};
                    pw[j][1] = (u32x4){cvtpk(p0[8], p0[9]), cvtpk(p0[10], p0[11]), cvtpk(p0[12], p0[13]), cvtpk(p0[14], p0[15])};
                    pw[j][2] = (u32x4){cvtpk(p1[0], p1[1]), cvtpk(p1[2], p1[3]), cvtpk(p1[4], p1[5]), cvtpk(p1[6], p1[7])};
                    pw[j][3] = (u32x4){cvtpk(p1[8], p1[9]), cvtpk(p1[10], p1[11]), cvtpk(p1[12], p1[13]), cvtpk(p1[14], p1[15])};
                }
            }
        } else {
            float mt = -INFINITY;
#pragma unroll 1
            for (int j = 0; j < 3; ++j) {
                const int tt = twlo + 2 - j;
                if (tt >= tt_lo) {
                    f32x16 p0, p1;
                    qkt(p0, p1, lds + L_K + tt * 8192, qr, 0.f, r32, hi);
                    const LAS float* tb = tab + (32 * wid + r32 + 192 - 64 * tt - 4 * hi - 63);
#pragma unroll
                    for (int r = 0; r < 16; ++r) mt = fmaxf(mt, fmaxf(p0[r] + tb[63 - crow(r, 0)], p1[r] + tb[31 - crow(r, 0)]));
                }
            }
            mt = other_half_max(mt);
            m_run = mt;
#pragma unroll
            for (int j = 0; j < 3; ++j) {
                const int tt = twlo + 2 - j;
                if (tt >= tt_lo) {
                    f32x16 p0, p1;
                    qkt(p0, p1, lds + L_K + tt * 8192, qr, -mt, r32, hi);
                    const LAS float* tb = tab + (32 * wid + r32 + 192 - 64 * tt - 4 * hi - 63);
#pragma unroll
                    for (int r = 0; r < 16; ++r) { p0[r] += tb[63 - crow(r, 0)]; p1[r] += tb[31 - crow(r, 0)]; }
                    exp_sum(p0, p1, l_part);
                    pw[j][0] = (u32x4){cvtpk(p0[0], p0[1]), cvtpk(p0[2], p0[3]), cvtpk(p0[4], p0[5]), cvtpk(p0[6], p0[7])};
                    pw[j][1] = (u32x4){cvtpk(p0[8], p0[9]), cvtpk(p0[10], p0[11]), cvtpk(p0[12], p0[13]), cvtpk(p0[14], p0[15])};
                    pw[j][2] = (u32x4){cvtpk(p1[0], p1[1]), cvtpk(p1[2], p1[3]), cvtpk(p1[4], p1[5]), cvtpk(p1[6], p1[7])};
                    pw[j][3] = (u32x4){cvtpk(p1[8], p1[9]), cvtpk(p1[10], p1[11]), cvtpk(p1[12], p1[13]), cvtpk(p1[14], p1[15])};
                }
            }
        }
        if (tid == 0) info[1] = (int)nextu;
        asm volatile("s_waitcnt vmcnt(0) lgkmcnt(0)\n\ts_barrier" ::: "memory");
        const int un2 = info[1];
        if (un < AT_NDIL) issue_k(un);
        f32x16 o[2]; o[0] = (f32x16){}; o[1] = (f32x16){};
#pragma unroll
        for (int j = 0; j < 3; ++j) {
            const int tt = twlo + 2 - j;
            if (tt >= tt_lo) att_pv_packed(o, pw[j], lds + L_V + tt * 8192, lane);
        }
        const float l_run = other_half_sum(l_part);
        const float oscale = 1.f / l_run, lse = ((dil_fixed ? m_dil : m_run) + __builtin_amdgcn_logf(l_run)) * LN2;
        asm volatile("s_waitcnt lgkmcnt(0)\n\ts_barrier" ::: "memory");
        {
            const size_t rb = (size_t)b * S;
            const int mw = 256 * nb2 + 32 * wid;
            bf16_t* O = dilo + (((size_t)p * 6 + h) * NTOK + rb) * 64;
            const size_t mw_row = (size_t)mw * dil + res;
            store_o(o, oscale, lds, wid, lane, [&](int row) { return O + (mw_row + (size_t)row * dil) * 64; }, [&](int row) { return (const bf16_t*)nullptr; }, false);
            if (hi == 0) dill[((size_t)p * 6 + h) * NTOK + rb + (size_t)(mw + r32) * dil + res] = lse;
        }
        prev_st = true;
        u = un; un = un2;
    }
    asm volatile("s_waitcnt vmcnt(0) lgkmcnt(0)\n\ts_barrier" ::: "memory");
}

__device__ __forceinline__ void mg_merge(const Args& a) {
    const bf16_t* dilo = (const bf16_t*)a.out;
    const float* dill = (const float*)(a.ws + WS_DILL);
    bf16_t* mix = (bf16_t*)(a.ws + WS_ACT);
    const int tid = opaque_tid();
    const size_t total = (size_t)6 * NTOK * 8;
    const size_t step = (size_t)gridDim.x * NTHR;
    for (size_t i0 = (size_t)blockIdx.x * NTHR + tid; i0 < total; i0 += 4 * step) {
        u32x4 a0[4], a1[4], a2[4]; float l0[4], l1[4], l2[4];
#pragma unroll
        for (int q = 0; q < 4; ++q) { const size_t i = i0 + q * step; if (i < total) { const size_t ht = i >> 3; const int c = (int)(i & 7);
            l0[q] = dill[(size_t)0 * 6 * NTOK + ht]; l1[q] = dill[(size_t)1 * 6 * NTOK + ht]; l2[q] = dill[(size_t)2 * 6 * NTOK + ht];
            a0[q] = __builtin_nontemporal_load((const u32x4*)(dilo + ((size_t)0 * 6 * NTOK + ht) * 64 + c * 8));
            a1[q] = __builtin_nontemporal_load((const u32x4*)(dilo + ((size_t)1 * 6 * NTOK + ht) * 64 + c * 8));
            a2[q] = __builtin_nontemporal_load((const u32x4*)(dilo + ((size_t)2 * 6 * NTOK + ht) * 64 + c * 8)); } }
#pragma unroll
        for (int q = 0; q < 4; ++q) { const size_t i = i0 + q * step; if (i < total) { const size_t ht = i >> 3; const int c = (int)(i & 7);
            const float mx = fmaxf(l0[q], fmaxf(l1[q], l2[q]));
            float w0 = __expf(l0[q] - mx), w1 = __expf(l1[q] - mx), w2 = __expf(l2[q] - mx);
            const float inv = 1.f / (w0 + w1 + w2); w0 *= inv; w1 *= inv; w2 *= inv;
            u32x4 r;
#pragma unroll
            for (int k = 0; k < 4; ++k) {
                const float x0 = w0 * __uint_as_float(a0[q][k] << 16) + w1 * __uint_as_float(a1[q][k] << 16) + w2 * __uint_as_float(a2[q][k] << 16);
                const float x1 = w0 * __uint_as_float(a0[q][k] & 0xffff0000u) + w1 * __uint_as_float(a1[q][k] & 0xffff0000u) + w2 * __uint_as_float(a2[q][k] & 0xffff0000u);
                r[k] = pk2(x0, x1);
            }
            *(u32x4*)(mix + ((size_t)4 * NTOK + ht) * 64 + c * 8) = r; } }
    }
}

__device__ __forceinline__ void cumsum_unit(const Args& a, LAS unsigned char* lds, int bh) {
    const int tid = opaque_tid(), b = bh >> 2, h = bh & 3;
    const float* flog = (const float*)(a.ws + WS_FLOG);
    float* cum = (float*)(a.ws + WS_CUM) + (size_t)bh * S;
    LAS double* sd = (LAS double*)lds;
    float fv[8];
#pragma unroll
    for (int j = 0; j < 8; ++j) fv[j] = flog[((size_t)b * S + tid * 8 + j) * 4 + h];
    double loc[8]; double run = 0.0;
#pragma unroll
    for (int j = 0; j < 8; ++j) { run += (double)fv[j]; loc[j] = run; }
    double incl = run;
#pragma unroll
    for (int o2 = 1; o2 < 64; o2 <<= 1) { const double t = __shfl_up(incl, o2); if ((tid & 63) >= o2) incl += t; }
    __syncthreads();
    if ((tid & 63) == 63) sd[tid >> 6] = incl;
    __syncthreads();
    double base = incl - run;
    for (int w = 0; w < (tid >> 6); ++w) base += sd[w];
#pragma unroll
    for (int j = 0; j < 8; ++j) cum[tid * 8 + j] = (float)(base + loc[j]);
    __syncthreads();
}
__device__ __forceinline__ void pj_mfma(const Args& a, LAS unsigned char* lds, int layer) {
    pg8::DenseOrder So; So.init(a.ws + WS_ACT, a.ws + WS_WIN + (size_t)layer * 3328 * D * 2, NTOK, 3328, D, gridDim.x, blockIdx.x);
    LAS float* gl = (LAS float*)(lds + SEG_OFF + 256);
    { const int t_ = opaque_tid(); if (t_ < 256) { const int w = t_ >> 6, i = t_ & 63; const float* gp_ = w == 0 ? a.in[I_QGF] : w == 1 ? a.in[I_KGF] : w == 2 ? a.in[I_QGD] : a.in[I_KGD]; gl[t_] = gp_[layer * 64 + i]; } }
    __syncthreads();
    EpiProj E{(bf16_t*)(a.ws + WS_PROJ), gl};
    pg8::gemm_phase<EpiProj, pg8::DenseOrder>(lds, D, So, E);
    if ((int)blockIdx.x >= (int)gridDim.x - 32) cumsum_unit(a, lds, blockIdx.x - (gridDim.x - 32));
    if (layer + 1 < NL) { __syncthreads(); constexpr int I_SPLIT = 10240;
        const int half = gridDim.x / 2; const bool upper = (int)blockIdx.x >= half;
        p0_prep(a, lds, layer + 1, upper ? half : 0, upper ? (int)gridDim.x - half : half, upper ? 0 : I_SPLIT, upper ? I_SPLIT : (1 << 30)); }
}
__device__ __forceinline__ void op_mfma(const Args& a, LAS unsigned char* lds, int layer, bf16_t* outp = nullptr) {
    pg8::DenseOrder So; So.init(a.ws + WS_ACT, a.ws + WS_WOUT + (size_t)layer * D * D * 2, NTOK, D, D, gridDim.x, blockIdx.x, (size_t)256 * 128);
    bf16_t* xb = (bf16_t*)(a.ws + WS_XB);
    EpiOut E{layer == 0 ? a.in[I_X] : nullptr, xb, outp ? outp : xb, (const float*)(a.ws + WS_MOD) + (size_t)layer * NB * 6144 + 2048};
    pg8::gemm_phase<EpiOut, pg8::DenseOrder>(lds, D, So, E, 128u, (size_t)NTOK * 128);
}
__device__ __forceinline__ void seg_to_lds(const Args& a, LAS unsigned char* lds, int layer) {
    LAS int* seg = (LAS int*)(lds + SEG_OFF);
    const int t = opaque_tid();
    if (t < 16) {
        unsigned* cnt = (unsigned*)(a.ws + WS_CTL) + CW_CNT + layer * 16 * 64;
        const int c = (int)__hip_atomic_load(cnt + t * 64, __ATOMIC_RELAXED, __HIP_MEMORY_SCOPE_AGENT);
        const int pad = (c + 255) & ~255;
        int incl = pad;
#pragma unroll
        for (int o2 = 1; o2 < 16; o2 <<= 1) { const int u2 = __shfl_up(incl, o2); if (t >= o2) incl += u2; }
        seg[t] = c; seg[16 + t] = incl - pad;
        if (t == 15) seg[32] = incl;
    }
    __syncthreads();
}
__device__ __forceinline__ void gu_mfma(const Args& a, LAS unsigned char* lds, int layer) {
    seg_to_lds(a, lds, layer);
    const LAS int* seg = (const LAS int*)(lds + SEG_OFF);
    pg8::GroupedOrder So{(const char*)(a.ws + WS_HS), (const char*)(a.ws + WS_WGU + (size_t)layer * NE * 1024 * D * 2), seg, 4, (int)gridDim.x, (int)blockIdx.x, (size_t)D * 2, (size_t)1024 * D * 2, (size_t)256 * D * 2};
    EpiGU E{(bf16_t*)(a.ws + WS_HID), seg};
    pg8::gemm_phase_gather<EpiGU, pg8::GroupedOrder>(lds, D, So, E, (const char*)(a.ws + WS_ACT), (const int*)(a.ws + WS_LIST), seg);
}
__device__ __forceinline__ void dn_mfma(const Args& a, LAS unsigned char* lds, int layer) {
    seg_to_lds(a, lds, layer);
    const LAS int* seg = (const LAS int*)(lds + SEG_OFF);
    pg8::GroupedOrder So{(const char*)(a.ws + WS_HID), (const char*)(a.ws + WS_WDN + (size_t)layer * NE * 1024 * DFF * 2), seg, 4, (int)gridDim.x, (int)blockIdx.x, (size_t)DFF * 2, (size_t)1024 * DFF * 2, (size_t)256 * DFF * 2};
    EpiDown E{(bf16_t*)(a.ws + WS_YBUF), (const int*)(a.ws + WS_LIST), (const float*)(a.ws + WS_LISTW), seg, lds};
    pg8::gemm_phase<EpiDown, pg8::GroupedOrder>(lds, DFF, So, E);
}

#ifndef MF_PJ
#define MF_PJ 1
#endif
#ifndef MF_OP
#define MF_OP 1
#endif
#ifndef MF_GU
#define MF_GU 1
#endif
#ifndef MF_AT
#define MF_AT 1
#endif
#ifndef MF_DN
#define MF_DN 1
#endif
__global__ void __launch_bounds__(NTHR, 2) mega_fwd(Args a) {
    extern __shared__ __attribute__((aligned(16))) unsigned char lds_raw[];
    LAS unsigned char* lds = (LAS unsigned char*)lds_raw;
    volatile LAS unsigned* MISC = (volatile LAS unsigned*)(lds + MISC_OFF);
    if (threadIdx.x < 32) MISC[threadIdx.x] = 0u;
    __syncthreads();
    XcdBarrier bar = xcd_barrier_post((unsigned*)(a.ws + WS_CTL) + CW_BAR, MISC + 8);

    p0_mod(a, lds);
    p0_prep(a, lds, 0, 0, gridDim.x);
    xcd_barrier(bar);
#pragma unroll 1
    for (int layer = 0; layer < NL; ++layer) {
        n1_norm(a, lds, layer);
        xcd_barrier(bar);
        pj_mfma(a, lds, layer);
        xcd_barrier(bar);
        at_mfma(a, lds, layer);
        if (AT_DIL_SPLIT) at_dil(a, lds, layer);
        xcd_barrier(bar);
        mg_merge(a);
        xcd_barrier(bar);
        op_mfma(a, lds, layer);
        xcd_barrier(bar);
        n2_mfma(a, lds, layer);
        xcd_barrier(bar);
        gu_mfma(a, lds, layer);
        xcd_barrier(bar);
        dn_mfma(a, lds, layer);
        xcd_barrier(bar);
    }
    fin_combine(a, NL - 1);
}

extern "C" void kernel_launch(void* const* d_in, const int* in_sizes, int n_in, void* d_out, int out_size, void* d_ws, size_t ws_size, hipStream_t stream) {
    static int grid = 0;
    if (grid == 0) {
        if (n_in != 19 || out_size != NTOK * D || ws_size < WS_END) { fprintf(stderr, "kernel_launch: unexpected shapes (n_in %d out %d ws %zu)\n", n_in, out_size, ws_size); grid = -1; return; }
        int dev = 0, cus = 0;
        if (hipGetDevice(&dev) != hipSuccess || hipDeviceGetAttribute(&cus, hipDeviceAttributeMultiprocessorCount, dev) != hipSuccess) { grid = -1; return; }
        if (hipFuncSetAttribute((const void*)mega_fwd, hipFuncAttributeMaxDynamicSharedMemorySize, LDS_BYTES) != hipSuccess) { fprintf(stderr, "kernel_launch: hipFuncSetAttribute failed\n"); grid = -1; return; }
        int per_cu = 0;
        if (hipOccupancyMaxActiveBlocksPerMultiprocessor(&per_cu, (const void*)mega_fwd, NTHR, LDS_BYTES) != hipSuccess || per_cu < 1) { fprintf(stderr, "kernel_launch: occupancy query says %d\n", per_cu); }
        (void)hipGetLastError();
        grid = cus;
    }
    if (grid < 0) return;
    if (hipMemsetAsync((char*)d_ws + WS_CTL, 0, CTL_ZERO_BYTES, stream) != hipSuccess) return;
    Args a{};
    for (int i = 0; i < 19; ++i) a.in[i] = (const float*)d_in[i];
    a.out = (float*)d_out; a.ws = (unsigned char*)d_ws;
    hipLaunchKernelGGL(mega_fwd, dim3(grid), dim3(NTHR), LDS_BYTES, stream, a);
}
```
